# Optimizing an MI355X kernel written in HIP

```python
import math
import jax, jax.numpy as jnp
from jax import lax
import numpy as np


D_MODEL = 1024
BATCH = 2
SEQ = 8192
DEPTH = 1

EPS = 1e-5
D_SSD = D_MODEL
SSD_HEAD_DIM = 64
SSD_HEADS = D_SSD // SSD_HEAD_DIM
SSD_GROUPS = 2
SSD_HEADS_PER_GROUP = SSD_HEADS // SSD_GROUPS
SSD_STATE = 128
CONV_WIDTH = 4
CHUNK = 128
D_XBC = D_SSD + 2 * SSD_GROUPS * SSD_STATE
D_ATTN = D_MODEL
ATTN_HEADS = 8
ATTN_QK_DIM = 64
ATTN_V_DIM = D_ATTN // ATTN_HEADS
D_QK = ATTN_HEADS * 2 * ATTN_QK_DIM
Q_BLOCK = 128
D_MIX = D_SSD + D_ATTN
SPLITS = [D_SSD,
          D_SSD + D_XBC,
          D_SSD + D_XBC + SSD_HEADS,
          D_SSD + D_XBC + SSD_HEADS + D_QK,
          D_SSD + D_XBC + SSD_HEADS + 2 * D_QK,
          D_SSD + D_XBC + SSD_HEADS + 2 * D_QK + D_ATTN]
D_IN_PROJ = SPLITS[-1] + D_ATTN

kernel_name = 'hybrid_ssd_diffattn_block'


def rms_norm(x, g):
    xf = x.astype(jnp.float32)
    y = xf * lax.rsqrt(jnp.mean(xf * xf, axis=-1, keepdims=True) + EPS)
    return (y * g.astype(jnp.float32)).astype(x.dtype)


def gated_group_rms_norm(y, z, g):
    bsz, seq, _ = y.shape
    t = (y.astype(jnp.float32) * jax.nn.silu(z.astype(jnp.float32)))
    t = t.reshape(bsz, seq, SSD_GROUPS, D_SSD // SSD_GROUPS)
    t = t * lax.rsqrt(jnp.mean(t * t, axis=-1, keepdims=True) + EPS)
    return (t.reshape(bsz, seq, D_SSD) * g.astype(jnp.float32)).astype(z.dtype)


def causal_depthwise_conv(u, w, b):
    ch = u.shape[-1]
    out = lax.conv_general_dilated(
        u, w[:, None, :], window_strides=(1,), padding=[(CONV_WIDTH - 1, 0)],
        dimension_numbers=('NWC', 'WIO', 'NWC'), feature_group_count=ch)
    return out + b


def ssd_chunked(x, dt, a, b_mat, c_mat):
    bsz, seq = x.shape[:2]
    nc = seq // CHUNK
    G, R, P, N = SSD_GROUPS, SSD_HEADS_PER_GROUP, SSD_HEAD_DIM, SSD_STATE
    xr = (x.astype(jnp.float32) * dt[..., None]).reshape(bsz, nc, CHUNK, G, R, P)
    adt = (dt * a).reshape(bsz, nc, CHUNK, G, R).transpose(0, 3, 4, 1, 2)
    a_cs = jnp.cumsum(adt, axis=-1)
    br = b_mat.astype(jnp.float32).reshape(bsz, nc, CHUNK, G, N)
    cr = c_mat.astype(jnp.float32).reshape(bsz, nc, CHUNK, G, N)
    causal = jnp.tril(jnp.ones((CHUNK, CHUNK), dtype=bool))
    seg = a_cs[..., :, None] - a_cs[..., None, :]
    lmat = jnp.exp(jnp.where(causal, seg, -jnp.inf))
    cb = jnp.einsum('bclgn,bcsgn->bgcls', cr, br)
    y_diag = jnp.einsum('bgcls,bgrcls,bcsgrp->bclgrp', cb, lmat, xr)
    decay = jnp.exp(a_cs[..., -1:] - a_cs)
    states = jnp.einsum('bclgn,bgrcl,bclgrp->bcgrpn', br, decay, xr)
    chunk_decay = jnp.exp(a_cs[..., -1])

    def step(hs, inp):
        s_c, d_c = inp
        return hs * d_c[..., None, None] + s_c, hs

    h0 = jnp.zeros((bsz, G, R, P, N), jnp.float32)
    _, prev = lax.scan(step, h0, (jnp.moveaxis(states, 1, 0), jnp.moveaxis(chunk_decay, -1, 0)))
    prev = jnp.moveaxis(prev, 0, 1)
    y_off = jnp.einsum('bclgn,bcgrpn,bgrcl->bclgrp', cr, prev, jnp.exp(a_cs))
    return (y_diag + y_off).reshape(bsz, seq, SSD_HEADS, P)


def alibi_slopes():
    return 2.0 ** (-(8.0 / ATTN_HEADS) * jnp.arange(1, ATTN_HEADS + 1, dtype=jnp.float32))


def diff_attention(q, k, v, lam, slopes):
    bsz, seq = q.shape[:2]
    nb = seq // Q_BLOCK
    qh = jnp.transpose(q, (0, 2, 3, 1, 4)) * (ATTN_QK_DIM ** -0.5)
    kh = jnp.transpose(k, (0, 2, 3, 1, 4))
    vh = jnp.transpose(v, (0, 2, 1, 3))
    qb = jnp.moveaxis(qh.reshape(bsz, ATTN_HEADS, 2, nb, Q_BLOCK, ATTN_QK_DIM), 3, 0)
    kpos = jnp.arange(seq)

    def block(args):
        qblk, i = args
        s = jnp.einsum('bhmqd,bhmkd->bhmqk', qblk, kh).astype(jnp.float32)
        qpos = i * Q_BLOCK + jnp.arange(Q_BLOCK)
        dist = qpos[:, None] - kpos[None, :]
        bias = -slopes[:, None, None, None] * dist.astype(jnp.float32)
        s = jnp.where(dist >= 0, s + bias, -jnp.inf)
        p = jax.nn.softmax(s, axis=-1)
        w = p[:, :, 0] - lam * p[:, :, 1]
        return jnp.einsum('bhqk,bhke->bhqe', w.astype(vh.dtype), vh)

    out = lax.map(block, (qb, jnp.arange(nb)))
    return jnp.transpose(out, (1, 0, 3, 2, 4)).reshape(bsz, seq, ATTN_HEADS, ATTN_V_DIM)


def setup_inputs(seed: int = 0) -> dict:
    key = jax.random.key(seed)
    ks = jax.random.split(key, 18)
    f32 = jnp.float32
    x = jax.random.normal(ks[0], (BATCH, SEQ, D_MODEL), f32)
    norm_gain = 1.0 + 0.02 * jax.random.normal(ks[1], (DEPTH, D_MODEL), f32)
    w_in = jax.random.normal(ks[2], (DEPTH, D_MODEL, D_IN_PROJ), f32) * D_MODEL ** -0.5
    conv_w = jax.random.normal(ks[3], (DEPTH, CONV_WIDTH, D_XBC), f32) * CONV_WIDTH ** -0.5
    conv_b = 0.02 * jax.random.normal(ks[4], (DEPTH, D_XBC), f32)
    u = jax.random.uniform(ks[5], (DEPTH, SSD_HEADS), f32)
    dt0 = jnp.exp(u * (math.log(0.1) - math.log(0.001)) + math.log(0.001))
    dt_bias = dt0 + jnp.log(-jnp.expm1(-dt0))
    a_log = jnp.log(jax.random.uniform(ks[6], (DEPTH, SSD_HEADS), f32, 1.0, 16.0))
    d_skip = 1.0 + 0.1 * jax.random.normal(ks[7], (DEPTH, SSD_HEADS), f32)
    ssd_norm_gain = 1.0 + 0.02 * jax.random.normal(ks[8], (DEPTH, D_SSD), f32)
    lambda_q1 = 0.1 * jax.random.normal(ks[9], (DEPTH, ATTN_QK_DIM), f32)
    lambda_k1 = 0.1 * jax.random.normal(ks[10], (DEPTH, ATTN_QK_DIM), f32)
    lambda_q2 = 0.1 * jax.random.normal(ks[11], (DEPTH, ATTN_QK_DIM), f32)
    lambda_k2 = 0.1 * jax.random.normal(ks[12], (DEPTH, ATTN_QK_DIM), f32)
    subln_gain = 1.0 + 0.02 * jax.random.normal(ks[13], (DEPTH, ATTN_V_DIM), f32)
    w_out = jax.random.normal(ks[14], (DEPTH, D_MIX, D_MODEL), f32) * D_MIX ** -0.5
    final_norm_gain = 1.0 + 0.02 * jax.random.normal(ks[15], (D_MODEL,), f32)
    return {'x': x, 'norm_gain': norm_gain, 'w_in': w_in, 'conv_w': conv_w,
            'conv_b': conv_b, 'dt_bias': dt_bias, 'a_log': a_log, 'd_skip': d_skip,
            'ssd_norm_gain': ssd_norm_gain, 'lambda_q1': lambda_q1,
            'lambda_k1': lambda_k1, 'lambda_q2': lambda_q2, 'lambda_k2': lambda_k2,
            'subln_gain': subln_gain, 'w_out': w_out, 'final_norm_gain': final_norm_gain}


def reference(x, norm_gain, w_in, conv_w, conv_b, dt_bias, a_log, d_skip,
              ssd_norm_gain, lambda_q1, lambda_k1, lambda_q2, lambda_k2,
              subln_gain, w_out, final_norm_gain):
    bsz, seq, _ = x.shape
    slopes = alibi_slopes()
    h = x
    for layer in range(DEPTH):
        u = rms_norm(h, norm_gain[layer])
        proj = jnp.einsum('bsd,de->bse', u, w_in[layer])
        z_ssd, xbc, dt_raw, q, k, v, z_attn = jnp.split(proj, SPLITS, axis=-1)

        xbc = jax.nn.silu(causal_depthwise_conv(xbc, conv_w[layer], conv_b[layer]))
        xs, bm, cm = jnp.split(xbc, [D_SSD, D_SSD + SSD_GROUPS * SSD_STATE], axis=-1)
        dt = jax.nn.softplus(dt_raw.astype(jnp.float32) + dt_bias[layer].astype(jnp.float32))
        a = -jnp.exp(a_log[layer].astype(jnp.float32))
        xs_h = xs.reshape(bsz, seq, SSD_HEADS, SSD_HEAD_DIM)
        y = ssd_chunked(xs_h, dt, a,
                        bm.reshape(bsz, seq, SSD_GROUPS, SSD_STATE),
                        cm.reshape(bsz, seq, SSD_GROUPS, SSD_STATE))
        y = y + xs_h.astype(jnp.float32) * d_skip[layer].astype(jnp.float32)[:, None]
        y_ssd = gated_group_rms_norm(y.reshape(bsz, seq, D_SSD), z_ssd, ssd_norm_gain[layer])

        lambda_init = 0.8 - 0.6 * math.exp(-0.3 * layer)
        lam = (jnp.exp(jnp.sum(lambda_q1[layer].astype(jnp.float32) * lambda_k1[layer].astype(jnp.float32)))
               - jnp.exp(jnp.sum(lambda_q2[layer].astype(jnp.float32) * lambda_k2[layer].astype(jnp.float32)))
               + lambda_init)
        attn = diff_attention(q.reshape(bsz, seq, ATTN_HEADS, 2, ATTN_QK_DIM),
                              k.reshape(bsz, seq, ATTN_HEADS, 2, ATTN_QK_DIM),
                              v.reshape(bsz, seq, ATTN_HEADS, ATTN_V_DIM), lam, slopes)
        attn = rms_norm(attn.astype(h.dtype), subln_gain[layer]) * (1.0 - lambda_init)
        y_attn = attn.reshape(bsz, seq, D_ATTN) * jax.nn.silu(z_attn)

        mixed = jnp.concatenate([y_ssd, y_attn.astype(h.dtype)], axis=-1)
        h = h + jnp.einsum('bse,ed->bsd', mixed, w_out[layer]).astype(h.dtype)
    return rms_norm(h, final_norm_gain)
```

```cpp
#include <hip/hip_runtime.h>
#include <hip/hip_cooperative_groups.h>
#include <cstdio>
#include <cstdint>
#include <cstddef>
#include <type_traits>
namespace cg = cooperative_groups;

typedef unsigned short u16;
typedef short bf16x8 __attribute__((ext_vector_type(8)));
typedef float f32x16 __attribute__((ext_vector_type(16)));
typedef uint32_t u32x4 __attribute__((ext_vector_type(4)));
typedef uint32_t u32x2 __attribute__((ext_vector_type(2)));
#define MFMA32(a, b, c) __builtin_amdgcn_mfma_f32_32x32x16_bf16((a), (b), (c), 0, 0, 0)

struct Params {
  const float* x; const float* norm_gain; const float* w_in; const float* conv_w; const float* conv_b;
  const float* dt_bias; const float* a_log; const float* d_skip; const float* ssd_norm_gain;
  const float* lq1; const float* lk1; const float* lq2; const float* lk2; const float* subln_gain;
  const float* w_out; const float* final_gain;
  float* out; char* ws;
};

constexpr int T_ = 16384;
constexpr float EPS = 1e-5f;
constexpr float LOG2E = 1.4426950408889634f;
constexpr int LDS_BYTES = 150 * 1024;
constexpr int NPAD = 6784;

constexpr size_t OFF_WOUTT = 0;
constexpr size_t OFF_PREV = 4194304;
constexpr size_t OFF_ZS = OFF_PREV + 33554432;
constexpr size_t OFF_XBC = OFF_ZS + 33554432;
constexpr size_t OFF_DT = OFF_XBC + 50331648;
constexpr size_t OFF_Q = OFF_DT + 1048576;
constexpr size_t OFF_K = OFF_Q + 33554432;
constexpr size_t OFF_VT = OFF_K + 33554432;
constexpr size_t OFF_ZA = OFF_VT + 33554432;
constexpr size_t OFF_CD = OFF_ZA + 33554432;
constexpr size_t OFF_ROWSS = OFF_CD + 8192;
constexpr size_t OFF_CTR = OFF_ROWSS + 65536;
constexpr size_t OFF_KMAX = OFF_CTR + 64;
constexpr size_t OFF_BAR = OFF_CTR + 256;
constexpr size_t OFF_RSTD = OFF_BAR + 16384;
constexpr size_t WS_NEED = OFF_RSTD + 131072;
constexpr size_t OOFF_WINT = 0;
constexpr size_t OOFF_U = 16777216;
constexpr size_t OOFF_XTG = 33554432;

typedef __bf16 bf16x2_t __attribute__((ext_vector_type(2)));
typedef float f32x2_t __attribute__((ext_vector_type(2)));
__device__ __forceinline__ uint32_t pack2(float a, float b) {
  f32x2_t v; v.x = a; v.y = b;
  return __builtin_bit_cast(uint32_t, __builtin_convertvector(v, bf16x2_t));
}
__device__ __forceinline__ u16 f2bf(float f) { return (u16)(pack2(f, 0.f) & 0xFFFFu); }
__device__ __forceinline__ float bf2f(uint32_t h) { return __uint_as_float(h << 16); }
__device__ __forceinline__ float bflo(uint32_t w) { return __uint_as_float(w << 16); }
__device__ __forceinline__ float bfhi(uint32_t w) { return __uint_as_float(w & 0xFFFF0000u); }
__device__ __forceinline__ float silu(float v) { return v * __builtin_amdgcn_rcpf(1.f + __expf(-v)); }
__device__ __forceinline__ float wave_sum(float v) {
#pragma unroll
  for (int o = 32; o > 0; o >>= 1) v += __shfl_xor(v, o);
  return v;
}


#define XB_TMO      128
#define XB_XCNT(j)  (256  + 64 * (j))
#define XB_XSUB(j)  (1280 + 64 * (j))
#define XB_XGEN(j)  (2304 + 64 * (j))
#define XB_TOP      3328
#define XB_TOPGEN   3392
#define XCD_BAR_WORDS 3456
#define XB_SPIN_CAP (1u << 18)
#define LAS __attribute__((address_space(3)))
__device__ __forceinline__ unsigned xb_ld(unsigned* p)              { return __hip_atomic_load(p, __ATOMIC_RELAXED, __HIP_MEMORY_SCOPE_AGENT); }
__device__ __forceinline__ unsigned xb_add(unsigned* p, unsigned v) { return __hip_atomic_fetch_add(p, v, __ATOMIC_RELAXED, __HIP_MEMORY_SCOPE_AGENT); }
__device__ __forceinline__ unsigned xb_xcc_id() { return (unsigned)__builtin_amdgcn_s_getreg((3 << 11) | 20) & 0xFu; }
#define XB_SPIN(cond, bar) do { unsigned _sp = 0; while (cond) { __builtin_amdgcn_s_sleep(1); \
    if ((++_sp & 255u) == 0u) { if (xb_ld(&(bar)[XB_TMO])) break; if (_sp > XB_SPIN_CAP) { atomicAdd(&(bar)[XB_TMO], 1u); break; } } } } while (0)
struct XcdBarrier { unsigned* bar; unsigned x; volatile LAS unsigned* st; };
__device__ __forceinline__ XcdBarrier xcd_barrier_post(unsigned* bar, volatile LAS unsigned* st) {
  XcdBarrier b; b.bar = bar; b.x = xb_xcc_id(); b.st = st;
  if (threadIdx.x == 0) st[2] = xb_add(&bar[XB_XCNT(b.x)], 1u);
  return b;
}
__device__ __forceinline__ void xcd_barrier_complete(unsigned* bar, unsigned x, unsigned& nloc, unsigned& nx) {
  const unsigned G = gridDim.x * gridDim.y * gridDim.z;
  unsigned sum, cnt, mine, sp = 0u;
  for (;;) {
    sum = 0u; cnt = 0u; mine = 0u;
#pragma unroll
    for (unsigned j = 0; j < 16; ++j) { const unsigned c = xb_ld(&bar[XB_XCNT(j)]); sum += c; cnt += (c > 0u) ? 1u : 0u; mine = (j == x) ? c : mine; }
    if (sum == G) break;
    __builtin_amdgcn_s_sleep(1);
    if ((++sp & 255u) == 0u) { if (xb_ld(&bar[XB_TMO])) break; if (sp > XB_SPIN_CAP) { atomicAdd(&bar[XB_TMO], 1u); break; } }
  }
  nloc = mine > 0u ? mine : 1u; nx = cnt > 0u ? cnt : 1u;
}
__device__ __forceinline__ void xcd_barrier(const XcdBarrier& b) {
  asm volatile("s_waitcnt vmcnt(0)" ::: "memory");
  __syncthreads();
  if (threadIdx.x == 0) {
    unsigned* bar = b.bar;
    __builtin_amdgcn_s_waitcnt(0);
    unsigned nloc = b.st[0], nx = b.st[1];
    if (nloc == 0u) { xcd_barrier_complete(bar, b.x, nloc, nx); b.st[0] = nloc; b.st[1] = nx; }
    const unsigned old = xb_add(&bar[XB_XSUB(b.x)], 1u);
    const unsigned gen = old / nloc;
    if (old + 1u == (gen + 1u) * nloc) {
      __builtin_amdgcn_fence(__ATOMIC_RELEASE, "agent");
      asm volatile("s_waitcnt vmcnt(0)" ::: "memory");
      const unsigned og = xb_add(&bar[XB_TOP], 1u);
      const unsigned tg = og / nx;
      if (og + 1u == (tg + 1u) * nx) xb_add(&bar[XB_TOPGEN], 1u);
      else XB_SPIN(xb_ld(&bar[XB_TOPGEN]) == tg, bar);
      __builtin_amdgcn_fence(__ATOMIC_ACQUIRE, "agent");
      xb_add(&bar[XB_XGEN(b.x)], 1u);
      asm volatile("s_waitcnt vmcnt(0)" ::: "memory");
    } else {
      XB_SPIN(xb_ld(&bar[XB_XGEN(b.x)]) == gen, bar);
      __builtin_amdgcn_fence(__ATOMIC_ACQUIRE, "agent");
      asm volatile("s_waitcnt vmcnt(0)" ::: "memory");
    }
  }
  __syncthreads();
}

__device__ __forceinline__ void phase_prep(const Params& p, char* smem) {
  const int tid = threadIdx.x, lane = tid & 63, wid = tid >> 6;
  float* tile = (float*)smem;
  u16* WinT = (u16*)((char*)p.out + OOFF_WINT);
  u16* WoutT = (u16*)(p.ws + OFF_WOUTT);
  u16* U = (u16*)((char*)p.out + OOFF_U);
  constexpr int NT_IN = (NPAD / 64) * 16;
  constexpr int NT_OUT = 16 * 32;
  struct TP { const float* src; u16* dst; int src_ld, dst_ld, k0, n0src, n0dst, nvalid; };
  auto tparams = [&](int t) {
    TP q;
    if (t < NT_IN) {
      const int nt = t >> 4, kt = t & 15; q.n0dst = nt * 64; q.k0 = kt * 64;
      if (q.n0dst < 2560) { q.n0src = q.n0dst; q.nvalid = 64; }
      else if (q.n0dst < 6656) { q.n0src = q.n0dst + 16; q.nvalid = 64; }
      else if (q.n0dst == 6656) { q.n0src = 2560; q.nvalid = 16; }
      else { q.n0src = 0; q.nvalid = 0; }
      q.src = p.w_in; q.src_ld = 6672; q.dst = WinT; q.dst_ld = 1024;
    } else {
      const int tt = t - NT_IN, nt = tt >> 5, kt = tt & 31; q.n0dst = nt * 64; q.n0src = q.n0dst; q.nvalid = 64; q.k0 = kt * 64;
      q.src = p.w_out; q.src_ld = 1024; q.dst = WoutT; q.dst_ld = 2048;
    }
    return q;
  };
  float nv[8];
  auto tload = [&](const TP& q) {
#pragma unroll
    for (int i = 0; i < 8; i++) {
      const int r = (tid >> 6) + 8 * i, c = tid & 63;
      nv[i] = (c < q.nvalid) ? q.src[(size_t)(q.k0 + r) * q.src_ld + q.n0src + c] : 0.f;
      if (q.src == p.w_out && q.k0 + r < 1024) nv[i] *= p.ssd_norm_gain[q.k0 + r];
    }
  };
  if (blockIdx.x < NT_IN + NT_OUT) tload(tparams(blockIdx.x));
  for (int t = blockIdx.x; t < NT_IN + NT_OUT; t += gridDim.x) {
    const TP q = tparams(t);
#pragma unroll
    for (int i = 0; i < 8; i++) tile[((tid >> 6) + 8 * i) * 65 + (tid & 63)] = nv[i];
    __syncthreads();
    if (t + (int)gridDim.x < NT_IN + NT_OUT) tload(tparams(t + gridDim.x));
    {
      const int n = tid >> 3, kc = (tid & 7) * 8;
      u32x4 o;
      o.x = pack2(tile[(kc + 0) * 65 + n], tile[(kc + 1) * 65 + n]);
      o.y = pack2(tile[(kc + 2) * 65 + n], tile[(kc + 3) * 65 + n]);
      o.z = pack2(tile[(kc + 4) * 65 + n], tile[(kc + 5) * 65 + n]);
      o.w = pack2(tile[(kc + 6) * 65 + n], tile[(kc + 7) * 65 + n]);
      *(u32x4*)(q.dst + (size_t)(q.n0dst + n) * q.dst_ld + q.k0 + kc) = o;
    }
    __syncthreads();
  }
  for (int row0 = (blockIdx.x * 8 + wid) * 8; row0 < T_; row0 += gridDim.x * 64) {
    float4 v[8][4]; float ss[8];
#pragma unroll
    for (int r = 0; r < 8; r++) {
      const float4* xr = (const float4*)(p.x + (size_t)(row0 + r) * 1024);
#pragma unroll
      for (int i = 0; i < 4; i++) v[r][i] = xr[lane + 64 * i];
    }
#pragma unroll
    for (int r = 0; r < 8; r++) {
      float t = 0.f;
#pragma unroll
      for (int i = 0; i < 4; i++) t += v[r][i].x * v[r][i].x + v[r][i].y * v[r][i].y + v[r][i].z * v[r][i].z + v[r][i].w * v[r][i].w;
      ss[r] = rsqrtf(wave_sum(t) * (1.f / 1024.f) + EPS);
    }
#pragma unroll
    for (int i = 0; i < 4; i++) {
      const float4 g = ((const float4*)p.norm_gain)[lane + 64 * i];
#pragma unroll
      for (int r = 0; r < 8; r++) {
        const float rs = ss[r];
        u32x2 o; o.x = pack2(v[r][i].x * rs * g.x, v[r][i].y * rs * g.y); o.y = pack2(v[r][i].z * rs * g.z, v[r][i].w * rs * g.w);
        *(u32x2*)(U + (size_t)(row0 + r) * 1024 + (lane + 64 * i) * 4) = o;
      }
    }
  }
}

__device__ __forceinline__ float dpp_xor1(float v) {
  return __builtin_bit_cast(float, __builtin_amdgcn_mov_dpp(__builtin_bit_cast(int, v), 0xB1, 0xF, 0xF, true));
}

template <int MODE, int NT, bool SWP>
__device__ __forceinline__ void gemm_tile(const Params& p, char* smem, int m0, int n0) {
  constexpr int KDIM = MODE == 0 ? 1024 : 2048;
  constexpr int KT = KDIM / 64;
  constexpr int LDT = 72;
  constexpr int BROWS = 64 * NT;
  constexpr int WN = 32 * NT;
  u16* As = (u16*)smem;
  u16* Bs = As + 2 * 256 * LDT;
  const int tid = threadIdx.x, lane = tid & 63, w = tid >> 6;
  const int wm = w & 3, wn = w >> 2, r32 = lane & 31, hh = lane >> 5;
  const u16* Wt = MODE == 0 ? (const u16*)((char*)p.out + OOFF_WINT) : (const u16*)(p.ws + OFF_WOUTT);
  const u16* A0 = MODE == 0 ? (const u16*)((char*)p.out + OOFF_U) : (const u16*)(p.ws + OFF_ZS);
  const u16* A1 = (const u16*)(p.ws + OFF_Q);
  const int lrow = tid >> 3, lcc = (tid & 7) * 8;
  f32x16 acc[2][NT];
#pragma unroll
  for (int i = 0; i < 2; i++)
#pragma unroll
    for (int j = 0; j < NT; j++)
#pragma unroll
      for (int r = 0; r < 16; r++) acc[i][j][r] = 0.f;
  u32x4 ra[4], rb[NT];
  const uint32_t aoff0 = (uint32_t)(m0 + lrow) * 2048u + (uint32_t)lcc * 2u;
  const uint32_t boff0 = (uint32_t)(n0 + lrow) * (uint32_t)(KDIM * 2) + (uint32_t)lcc * 2u;
  auto gload = [&](int kt) {
    const char* abase = (const char*)((MODE == 0 || kt < 16) ? A0 : A1);
    const uint32_t ao = aoff0 + (uint32_t)(kt & 15) * 128u;
    const uint32_t bo = boff0 + (uint32_t)kt * 128u;
#pragma unroll
    for (int i = 0; i < 4; i++) ra[i] = *(const u32x4*)(abase + (ao + (uint32_t)i * (64u * 2048u)));
#pragma unroll
    for (int i = 0; i < NT; i++) rb[i] = *(const u32x4*)((const char*)Wt + (bo + (uint32_t)i * (uint32_t)(64 * KDIM * 2)));
  };
  auto lstore = [&](int buf) {
#pragma unroll
    for (int i = 0; i < 4; i++) *(u32x4*)(As + buf * 256 * LDT + (lrow + 64 * i) * LDT + lcc) = ra[i];
#pragma unroll
    for (int i = 0; i < NT; i++) *(u32x4*)(Bs + buf * 256 * LDT + (lrow + 64 * i) * LDT + lcc) = rb[i];
  };
  float rs0[2] = {1.f, 1.f}, rs1[2] = {1.f, 1.f};
  if (MODE == 1 && SWP) {
    const float* RS = (const float*)(p.ws + OFF_RSTD);
#pragma unroll
    for (int i = 0; i < 2; i++) { const float2 r = *(const float2*)(RS + (m0 + wm * 64 + i * 32 + r32) * 2); rs0[i] = r.x * __builtin_amdgcn_rcpf(r.y); rs1[i] = r.y; }
  }
  gload(0); lstore(0);
  __syncthreads();
  for (int kt = 0; kt < KT; kt++) {
    const int buf = kt & 1;
    if (kt + 1 < KT) gload(kt + 1);
    const u16* a_base = As + buf * 256 * LDT + (wm * 64 + r32) * LDT + hh * 8;
    const u16* b_base = Bs + buf * 256 * LDT + (wn * WN + r32) * LDT + hh * 8;
#pragma unroll
    for (int ks = 0; ks < 4; ks++) {
      bf16x8 af[2], bfr[NT];
#pragma unroll
      for (int i = 0; i < 2; i++) af[i] = *(const bf16x8*)(a_base + i * 32 * LDT + ks * 16);
#pragma unroll
      for (int j = 0; j < NT; j++) bfr[j] = *(const bf16x8*)(b_base + j * 32 * LDT + ks * 16);
#pragma unroll
      for (int i = 0; i < 2; i++)
#pragma unroll
        for (int j = 0; j < NT; j++) acc[i][j] = SWP ? MFMA32(bfr[j], af[i], acc[i][j]) : MFMA32(af[i], bfr[j], acc[i][j]);
      __builtin_amdgcn_sched_barrier(0);
      if (kt + 1 < KT) {
        u16* an = As + (buf ^ 1) * 256 * LDT + lrow * LDT + lcc;
        u16* bn = Bs + (buf ^ 1) * 256 * LDT + lrow * LDT + lcc;
        if (ks == 1) { *(u32x4*)(an) = ra[0]; *(u32x4*)(an + 64 * LDT) = ra[1]; *(u32x4*)(an + 128 * LDT) = ra[2]; }
        if (ks == 2) { *(u32x4*)(an + 192 * LDT) = ra[3]; *(u32x4*)(bn) = rb[0]; *(u32x4*)(bn + 64 * LDT) = rb[1]; }
        if (ks == 3 && NT == 4) { *(u32x4*)(bn + 128 * LDT) = rb[NT - 2]; *(u32x4*)(bn + 192 * LDT) = rb[NT - 1]; }
      }
    }
    if (MODE == 1 && SWP && (kt == 7 || kt == 15)) {
#pragma unroll
      for (int i = 0; i < 2; i++) {
        const float sc = (kt == 7) ? rs0[i] : rs1[i];
#pragma unroll
        for (int j = 0; j < NT; j++)
#pragma unroll
          for (int r = 0; r < 16; r++) acc[i][j][r] *= sc;
      }
    }
    __syncthreads();
  }
  if (SWP) {
    const int row0 = m0 + wm * 64 + r32;
    if (MODE == 0) {
      if (n0 == 6656) {
        if (wn == 0) {
          float* DT = (float*)(p.ws + OFF_DT);
#pragma unroll
          for (int mt = 0; mt < 2; mt++)
#pragma unroll
            for (int g = 0; g < 2; g++) {
              const int c0 = 8 * g + 4 * hh;
              const float4 bias = *(const float4*)(p.dt_bias + c0);
              float4 o;
              { const float v = acc[mt][0][4 * g + 0] + bias.x; o.x = fmaxf(v, 0.f) + log1pf(__expf(-fabsf(v))); }
              { const float v = acc[mt][0][4 * g + 1] + bias.y; o.y = fmaxf(v, 0.f) + log1pf(__expf(-fabsf(v))); }
              { const float v = acc[mt][0][4 * g + 2] + bias.z; o.z = fmaxf(v, 0.f) + log1pf(__expf(-fabsf(v))); }
              { const float v = acc[mt][0][4 * g + 3] + bias.w; o.w = fmaxf(v, 0.f) + log1pf(__expf(-fabsf(v))); }
              *(float4*)(DT + (row0 + mt * 32) * 16 + c0) = o;
            }
        }
      } else if (n0 >= 4608 && n0 < 5632) {
        u16* VT = (u16*)(p.ws + OFF_VT);
        const int q4 = lane & 3;
        const bool q1 = q4 & 1, q2 = q4 & 2;
#pragma unroll
        for (int mt = 0; mt < 2; mt++) {
          const int t0 = (row0 + mt * 32) & ~3;
          const uint32_t tb = ((uint32_t)((t0 >> 13) * 1024 + (n0 - 4608 + wn * WN + 4 * hh + q4)) * 8192u + (uint32_t)(t0 & 8191)) * 2u;
#pragma unroll
          for (int nt = 0; nt < NT; nt++)
#pragma unroll
            for (int g = 0; g < 4; g++) {
              const float a0 = acc[mt][nt][4 * g + 0], a1 = acc[mt][nt][4 * g + 1], a2 = acc[mt][nt][4 * g + 2], a3 = acc[mt][nt][4 * g + 3];
              const float r1 = dpp_xor1(q1 ? a0 : a1), r3 = dpp_xor1(q1 ? a2 : a3);
              const uint32_t p01 = q1 ? pack2(r1, a1) : pack2(a0, r1);
              const uint32_t p23 = q1 ? pack2(r3, a3) : pack2(a2, r3);
              const uint32_t rx = (uint32_t)__builtin_amdgcn_mov_dpp((int)(q2 ? p01 : p23), 0x4E, 0xF, 0xF, true);
              u32x2 o; o.x = q2 ? rx : p01; o.y = q2 ? p23 : rx;
              *(u32x2*)((char*)VT + (tb + (uint32_t)(nt * 32 + 8 * g) * 16384u)) = o;
            }
        }
      } else {
        u16* dst; int ld, coff; float scale = 1.f;
        if (n0 < 1024) { dst = (u16*)(p.ws + OFF_ZS); ld = 1024; coff = 0; }
        else if (n0 < 2560) { dst = (u16*)(p.ws + OFF_XBC); ld = 1536; coff = 1024; }
        else if (n0 < 3584) { dst = (u16*)(p.ws + OFF_Q); ld = 1024; coff = 2560; scale = 0.125f * LOG2E; }
        else if (n0 < 4608) { dst = (u16*)(p.ws + OFF_K); ld = 1024; coff = 3584; }
        else { dst = (u16*)(p.ws + OFF_ZA); ld = 1024; coff = 5632; }
#pragma unroll
        for (int mt = 0; mt < 2; mt++) {
          const uint32_t rowb = ((uint32_t)(row0 + mt * 32) * (uint32_t)ld + (uint32_t)(n0 + wn * WN - coff + (hh ? 8 : 0))) * 2u;
#pragma unroll
          for (int nt = 0; nt < NT; nt++)
#pragma unroll
            for (int k = 0; k < 4; k += 2) {
              uint32_t ax = pack2(acc[mt][nt][4 * k + 0] * scale, acc[mt][nt][4 * k + 1] * scale);
              uint32_t ay = pack2(acc[mt][nt][4 * k + 2] * scale, acc[mt][nt][4 * k + 3] * scale);
              uint32_t bx = pack2(acc[mt][nt][4 * k + 4] * scale, acc[mt][nt][4 * k + 5] * scale);
              uint32_t by = pack2(acc[mt][nt][4 * k + 6] * scale, acc[mt][nt][4 * k + 7] * scale);
              { auto r = __builtin_amdgcn_permlane32_swap(ax, bx, false, false); ax = r[0]; bx = r[1]; }
              { auto r = __builtin_amdgcn_permlane32_swap(ay, by, false, false); ay = r[0]; by = r[1]; }
              u32x4 o; o.x = ax; o.y = ay; o.z = bx; o.w = by;
              *(u32x4*)((char*)dst + (rowb + (uint32_t)((nt * 32 + 8 * k) * 2))) = o;
            }
        }
        if (n0 >= 3584 && n0 < 4608) {
#pragma unroll
          for (int grp = 0; grp < NT / 2; grp++) {
            float mx = 0.f;
#pragma unroll
            for (int mt = 0; mt < 2; mt++) {
              float v = 0.f;
#pragma unroll
              for (int reg = 0; reg < 16; reg++) v += acc[mt][2 * grp][reg] * acc[mt][2 * grp][reg] + acc[mt][2 * grp + 1][reg] * acc[mt][2 * grp + 1][reg];
              v += __shfl_xor(v, 32);
              mx = fmaxf(mx, v);
            }
#pragma unroll
            for (int o = 1; o < 32; o <<= 1) mx = fmaxf(mx, __shfl_xor(mx, o));
            if (lane == 0) atomicMax((unsigned int*)(p.ws + OFF_KMAX) + (m0 >> 13) * 16 + ((n0 - 3584 + wn * WN + grp * 64) >> 6), __float_as_uint(mx));
          }
        }
      }
    } else {
#pragma unroll
      for (int mt = 0; mt < 2; mt++) {
        const uint32_t rowb = ((uint32_t)(row0 + mt * 32) * 1024u + (uint32_t)(n0 + wn * WN + 4 * hh)) * 4u;
#pragma unroll
        for (int nt = 0; nt < NT; nt++)
#pragma unroll
          for (int g = 0; g < 4; g++) {
            const uint32_t idx = rowb + (uint32_t)((nt * 32 + 8 * g) * 4);
            const float4 xv = *(const float4*)((const char*)p.x + idx);
            float4 o;
            o.x = xv.x + acc[mt][nt][4 * g + 0]; o.y = xv.y + acc[mt][nt][4 * g + 1];
            o.z = xv.z + acc[mt][nt][4 * g + 2]; o.w = xv.w + acc[mt][nt][4 * g + 3];
            *(float4*)((char*)p.out + idx) = o;
          }
      }
    }
    return;
  }
  const int rbase = m0 + wm * 64 + 4 * hh;
  const int cbase = n0 + wn * WN + r32;
  const bool odd = lane & 1;
  if (MODE == 0) {
    if (n0 >= 4608 && n0 < 5632) {
      u16* VT = (u16*)(p.ws + OFF_VT);
#pragma unroll
      for (int mt = 0; mt < 2; mt++)
#pragma unroll
        for (int nt = 0; nt < NT; nt++)
#pragma unroll
          for (int rg = 0; rg < 4; rg++) {
            const int row0 = rbase + mt * 32 + 8 * rg;
            const int c = cbase + nt * 32 - 4608;
            const int bb = row0 >> 13, sq = row0 & 8191;
            u32x2 o; o.x = pack2(acc[mt][nt][rg * 4 + 0], acc[mt][nt][rg * 4 + 1]); o.y = pack2(acc[mt][nt][rg * 4 + 2], acc[mt][nt][rg * 4 + 3]);
            *(u32x2*)((char*)VT + ((uint32_t)(bb * 1024 + c) * 8192u + (uint32_t)sq) * 2u) = o;
          }
    } else if (NT == 2 && n0 == 6656) {
      if (wn == 0 && r32 < 16) {
        float* DT = (float*)(p.ws + OFF_DT);
        const float bias = p.dt_bias[r32];
#pragma unroll
        for (int mt = 0; mt < 2; mt++)
#pragma unroll
          for (int reg = 0; reg < 16; reg++) {
            const int row = rbase + mt * 32 + (reg & 3) + 8 * (reg >> 2);
            const float v = acc[mt][0][reg] + bias;
            DT[row * 16 + r32] = fmaxf(v, 0.f) + log1pf(__expf(-fabsf(v)));
          }
      }
    } else {
      u16* dst; int ld, coff; float scale = 1.f;
      if (n0 < 1024) { dst = (u16*)(p.ws + OFF_ZS); ld = 1024; coff = 0; }
      else if (n0 < 2560) { dst = (u16*)(p.ws + OFF_XBC); ld = 1536; coff = 1024; }
      else if (n0 < 3584) { dst = (u16*)(p.ws + OFF_Q); ld = 1024; coff = 2560; scale = 0.125f * LOG2E; }
      else if (n0 < 4608) { dst = (u16*)(p.ws + OFF_K); ld = 1024; coff = 3584; }
      else { dst = (u16*)(p.ws + OFF_ZA); ld = 1024; coff = 5632; }
#pragma unroll
      for (int mt = 0; mt < 2; mt++)
#pragma unroll
        for (int nt = 0; nt < NT; nt++)
#pragma unroll
          for (int t = 0; t < 8; t++) {
            const float va = acc[mt][nt][2 * t] * scale, vb = acc[mt][nt][2 * t + 1] * scale;
            const float recv = dpp_xor1(odd ? va : vb);
            const int reg = 2 * t + (odd ? 1 : 0);
            const int row = rbase + mt * 32 + (reg & 3) + 8 * (reg >> 2);
            const int col = ((cbase + nt * 32) & ~1) - coff;
            *(uint32_t*)((char*)dst + ((uint32_t)row * (uint32_t)ld + (uint32_t)col) * 2u) = odd ? pack2(recv, vb) : pack2(va, recv);
          }
      if (n0 >= 3584 && n0 < 4608) {
#pragma unroll
        for (int grp = 0; grp < NT / 2; grp++) {
          float mx = 0.f;
#pragma unroll
          for (int mt = 0; mt < 2; mt++)
#pragma unroll
            for (int reg = 0; reg < 16; reg++) {
              float v = acc[mt][2 * grp][reg] * acc[mt][2 * grp][reg] + acc[mt][2 * grp + 1][reg] * acc[mt][2 * grp + 1][reg];
#pragma unroll
              for (int o = 1; o < 32; o <<= 1) v += __shfl_xor(v, o);
              mx = fmaxf(mx, v);
            }
          mx = fmaxf(mx, __shfl_xor(mx, 32));
          if (lane == 0) atomicMax((unsigned int*)(p.ws + OFF_KMAX) + (m0 >> 13) * 16 + ((n0 - 3584 + wn * WN + grp * 64) >> 6), __float_as_uint(mx));
        }
      }
    }
  } else {
#pragma unroll
    for (int mt = 0; mt < 2; mt++)
#pragma unroll
      for (int nt = 0; nt < NT; nt++)
#pragma unroll
        for (int t = 0; t < 8; t++) {
          const float va = acc[mt][nt][2 * t], vb = acc[mt][nt][2 * t + 1];
          const float recv = dpp_xor1(odd ? va : vb);
          const int reg = 2 * t + (odd ? 1 : 0);
          const int row = rbase + mt * 32 + (reg & 3) + 8 * (reg >> 2);
          const int col = (cbase + nt * 32) & ~1;
          const uint32_t idx = ((uint32_t)row * 1024u + (uint32_t)col) * 4u;
          const float2 xv = *(const float2*)((const char*)p.x + idx);
          float2 o;
          o.x = xv.x + (odd ? recv : va); o.y = xv.y + (odd ? vb : recv);
          *(float2*)((char*)p.out + idx) = o;
        }
  }
}

__device__ __forceinline__ void dt_piece(const Params& p, char* smem, int m0) {
  const int tid = threadIdx.x, lane = tid & 63, w = tid >> 6, r32 = lane & 31, hh = lane >> 5;
  const u16* U = (const u16*)((const char*)p.out + OOFF_U);
  const u16* Wd = (const u16*)((const char*)p.out + OOFF_WINT) + (size_t)6656 * 1024;
  float* red = (float*)smem;
  f32x16 acc[2];
#pragma unroll
  for (int i = 0; i < 2; i++)
#pragma unroll
    for (int r = 0; r < 16; r++) acc[i][r] = 0.f;
  bf16x8 af[2][8], bfr[8];
  const int kb = w * 128 + hh * 8;
#pragma unroll
  for (int ks = 0; ks < 8; ks++) {
    bfr[ks] = *(const bf16x8*)(Wd + (size_t)r32 * 1024 + kb + ks * 16);
#pragma unroll
    for (int i = 0; i < 2; i++) af[i][ks] = *(const bf16x8*)(U + (size_t)(m0 + i * 32 + r32) * 1024 + kb + ks * 16);
  }
#pragma unroll
  for (int ks = 0; ks < 8; ks++)
#pragma unroll
    for (int i = 0; i < 2; i++) acc[i] = MFMA32(af[i][ks], bfr[ks], acc[i]);
  __syncthreads();
#pragma unroll
  for (int i = 0; i < 2; i++)
#pragma unroll
    for (int reg = 0; reg < 16; reg++)
      red[(w * 64 + i * 32 + (reg & 3) + 8 * (reg >> 2) + 4 * hh) * 32 + r32] = acc[i][reg];
  __syncthreads();
  float* DT = (float*)(p.ws + OFF_DT);
#pragma unroll
  for (int o = tid; o < 1024; o += 512) {
    const int row = o >> 4, col = o & 15;
    float v = p.dt_bias[col];
#pragma unroll
    for (int ww = 0; ww < 8; ww++) v += red[(ww * 64 + row) * 32 + col];
    DT[(m0 + row) * 16 + col] = fmaxf(v, 0.f) + log1pf(__expf(-fabsf(v)));
  }
  __syncthreads();
}

template <int MODE>
__device__ __forceinline__ void gemm_phase(const Params& p, char* smem, bool dry, int vbid) {
  (void)dry;
  const int bid = vbid;
  if (gridDim.x == 256) {
    const int x = bid & 7, j = bid >> 3;
    const int m0 = (x * 8 + (j & 7)) * 256, nq = j >> 3;
    if (MODE == 0) {
#pragma unroll 1
      for (int r = 0; r < 6; r++) {
        const int n0 = (r * 4 + nq) * 256;
        gemm_tile<0, 4, false>(p, smem, m0, n0);
      }
      gemm_tile<0, 2, false>(p, smem, m0, 6144 + nq * 128);
      dt_piece(p, smem, (int)blockIdx.x * 64);
    } else {
      gemm_tile<1, 4, true>(p, smem, m0, nq * 256);
    }
  } else {
    constexpr int NTN = MODE == 0 ? 53 : 8;
    for (int tile = bid; tile < 64 * NTN; tile += gridDim.x) {
      const int n0 = (tile >> 6) * 128;
      gemm_tile<MODE, 2, MODE == 1>(p, smem, (tile & 63) * 256, n0);
    }
  }
}

template <typename F>
__device__ __forceinline__ void conv_run32(const u16* xbc0, int col, bool first_chunk, int l0, const float* cw, const float* cb, F f) {
  const float w0 = cw[col], w1 = cw[1536 + col], w2 = cw[2 * 1536 + col], w3 = cw[3 * 1536 + col], bias = cb[col];
  float u[35];
#pragma unroll
  for (int i = 0; i < 35; i++) {
    const int l = l0 - 3 + i;
    u[i] = (first_chunk && l < 0) ? 0.f : bf2f((uint32_t)xbc0[(ptrdiff_t)l * 1536 + col]);
  }
#pragma unroll
  for (int i = 0; i < 32; i++) {
    const float v = w0 * u[i] + w1 * u[i + 1] + w2 * u[i + 2] + w3 * u[i + 3] + bias;
    f(i, silu(v));
  }
}

__device__ __forceinline__ void phase_states(const Params& p, char* smem) {
  u16* BT = (u16*)smem;
  u16* XT = BT + 128 * 136;
  float* wl = (float*)(XT + 2 * 64 * 136);
  const int tid = threadIdx.x, lane = tid & 63, w = tid >> 6, r32 = lane & 31, hh = lane >> 5;
  const int hg = w >> 2, wq = w & 3;
  const u16* XBC = (const u16*)(p.ws + OFF_XBC);
  const float* DT = (const float*)(p.ws + OFF_DT);
  float* CD = (float*)(p.ws + OFF_CD);
  u16* ST = (u16*)p.out;
  for (int item = blockIdx.x; item < 256; item += gridDim.x) {
    const int g = item & 1, bc = item >> 1, c = bc & 63, b = bc >> 6;
    const int tok0 = b * 8192 + c * 128;
    const u16* xbc0 = XBC + (size_t)tok0 * 1536;
    const float dtv0 = DT[(tok0 + 2 * lane) * 16 + g * 8 + w], dtv1 = DT[(tok0 + 2 * lane + 1) * 16 + g * 8 + w];
    {
      const int ch = tid & 127, q = tid >> 7;
      u16* dst = BT + ch * 136 + q * 32;
      uint32_t pk[16];
      conv_run32(xbc0, 1024 + g * 128 + ch, c == 0, q * 32, p.conv_w, p.conv_b, [&](int i, float v) {
        const uint32_t hb = f2bf(v);
        if (i & 1) pk[i >> 1] |= hb << 16; else pk[i >> 1] = hb;
      });
#pragma unroll
      for (int j = 0; j < 4; j++) { u32x4 o; o.x = pk[4 * j]; o.y = pk[4 * j + 1]; o.z = pk[4 * j + 2]; o.w = pk[4 * j + 3]; *(u32x4*)(dst + 8 * j) = o; }
    }
    {
      const int h = g * 8 + w;
      const float v0 = dtv0, v1 = dtv1;
      float sc = v0 + v1;
#pragma unroll
      for (int d = 1; d < 64; d <<= 1) { float t = __shfl_up(sc, d); if (lane >= d) sc += t; }
      const float A = -__expf(p.a_log[h]);
      const float tot = __shfl(sc, 63);
      const float e = sc - (v0 + v1);
      wl[w * 128 + 2 * lane] = v0 * __expf(A * (tot - (e + v0)));
      wl[w * 128 + 2 * lane + 1] = v1 * __expf(A * (tot - sc));
      if (lane == 0) CD[bc * 16 + h] = __expf(A * tot);
    }
    for (int hi = 0; hi < 4; hi++) {
      const int hl = hg * 4 + hi, h = g * 8 + hl;
      __syncthreads();
      {
        const int t = tid & 255, ch = t & 63, q = t >> 6;
        u16* dst = XT + hg * 64 * 136 + ch * 136 + q * 32;
        const float* wlh = wl + hl * 128 + q * 32;
        uint32_t pk[16], pg[16];
        float pv = 0.f, ps = 0.f;
        conv_run32(xbc0, h * 64 + ch, c == 0, q * 32, p.conv_w, p.conv_b, [&](int i, float v) {
          const float sc = v * wlh[i];
          if (i & 1) { pk[i >> 1] = pack2(ps, sc); pg[i >> 1] = pack2(pv, v); } else { pv = v; ps = sc; }
        });
        u16* dstg = (u16*)((char*)p.out + OOFF_XTG) + ((size_t)(bc * 16 + h) * 64 + ch) * 128 + q * 32;
#pragma unroll
        for (int j = 0; j < 4; j++) {
          u32x4 o; o.x = pk[4 * j]; o.y = pk[4 * j + 1]; o.z = pk[4 * j + 2]; o.w = pk[4 * j + 3]; *(u32x4*)(dst + 8 * j) = o;
          u32x4 og; og.x = pg[4 * j]; og.y = pg[4 * j + 1]; og.z = pg[4 * j + 2]; og.w = pg[4 * j + 3]; *(u32x4*)(dstg + 8 * j) = og;
        }
      }
      __syncthreads();
      {
        const u16* xt = XT + hg * 64 * 136;
        f32x16 acc[2];
#pragma unroll
        for (int mt = 0; mt < 2; mt++)
#pragma unroll
          for (int r = 0; r < 16; r++) acc[mt][r] = 0.f;
#pragma unroll
        for (int ks = 0; ks < 8; ks++) {
          const bf16x8 bb = *(const bf16x8*)(BT + (wq * 32 + r32) * 136 + ks * 16 + hh * 8);
#pragma unroll
          for (int mt = 0; mt < 2; mt++) {
            const bf16x8 a = *(const bf16x8*)(xt + (mt * 32 + r32) * 136 + ks * 16 + hh * 8);
            acc[mt] = MFMA32(a, bb, acc[mt]);
          }
        }
        u16* dst = ST + ((size_t)(bc * 16 + h) * 64) * 128;
#pragma unroll
        for (int mt = 0; mt < 2; mt++)
#pragma unroll
          for (int reg = 0; reg < 16; reg++) {
            const int pp = mt * 32 + (reg & 3) + 8 * (reg >> 2) + 4 * hh;
            dst[pp * 128 + wq * 32 + r32] = f2bf(acc[mt][reg]);
          }
      }
    }
    __syncthreads();
  }
}

__device__ __forceinline__ void phase_scan(const Params& p) {
  const u16* ST = (const u16*)p.out;
  const float* CD = (const float*)(p.ws + OFF_CD);
  u16* PREV = (u16*)(p.ws + OFF_PREV);
  for (int idx = blockIdx.x * 512 + threadIdx.x; idx < 131072; idx += gridDim.x * 512) {
    const int e = idx * 2;
    const int b = e >> 17, rem = e & 131071, h = rem >> 13;
    float hx = 0.f, hy = 0.f;
#pragma unroll 32
    for (int c = 0; c < 64; c++) {
      const size_t off = (size_t)(b * 64 + c) * 131072 + rem;
      const uint32_t sw = *(const uint32_t*)(ST + off);
      float2 s; s.x = bflo(sw); s.y = bfhi(sw);
      const float d = CD[(b * 64 + c) * 16 + h];
      *(uint32_t*)(PREV + off) = pack2(hx, hy);
      hx = hx * d + s.x; hy = hy * d + s.y;
    }
  }
}

__device__ __forceinline__ void ssd_out_item(const Params& p, char* smem, int item, bool dry) {
  const int g = item & 1, bc = item >> 1, c = bc & 63, b = bc >> 6;
  const int tok0 = b * 8192 + c * 128;
  u16* R1 = (u16*)smem;
  u16* R2 = R1 + 128 * 136;
  u16* XT = R2 + 128 * 136;
  float* dts = (float*)(XT + 2 * 64 * 136);
  float* acs = dts + 1024;
  float* part = acs + 1024;
  float* rstd = part + 256;
  u16* PVB = (u16*)(rstd + 128);
  const int tid = threadIdx.x, lane = tid & 63, w = tid >> 6, r32 = lane & 31, hh = lane >> 5;
  const int lt = w & 3, hg = w >> 2;
  const u16* xbc0 = (const u16*)(p.ws + OFF_XBC) + (size_t)tok0 * 1536;
  const float* DT = (const float*)(p.ws + OFF_DT);
  u16* ZS = (u16*)(p.ws + OFF_ZS);
  const u16* PREV = (const u16*)(p.ws + OFF_PREV);
  const bool first = (c == 0);
  const float dtv0 = DT[(tok0 + 2 * lane) * 16 + g * 8 + w], dtv1 = DT[(tok0 + 2 * lane + 1) * 16 + g * 8 + w];
  {
    const int ch = tid & 127, q = tid >> 7;
    conv_run32(xbc0, 1280 + g * 128 + ch, first, q * 32, p.conv_w, p.conv_b, [&](int i, float v) { R1[(q * 32 + i) * 136 + ch] = f2bf(v); });
    conv_run32(xbc0, 1024 + g * 128 + ch, first, q * 32, p.conv_w, p.conv_b, [&](int i, float v) { R2[(q * 32 + i) * 136 + ch] = f2bf(v); });
  }
  {
    const int h = g * 8 + w;
    const float v0 = dtv0, v1 = dtv1;
    float sc = v0 + v1;
#pragma unroll
    for (int d = 1; d < 64; d <<= 1) { float t = __shfl_up(sc, d); if (lane >= d) sc += t; }
    const float A = -__expf(p.a_log[h]);
    const float e = sc - (v0 + v1);
    dts[w * 128 + 2 * lane] = v0; dts[w * 128 + 2 * lane + 1] = v1;
    acs[w * 128 + 2 * lane] = A * (e + v0); acs[w * 128 + 2 * lane + 1] = A * sc;
  }
  __syncthreads();
  const u16* cfp = R1 + (lt * 32 + r32) * 136 + hh * 8;
  float ss[16];
#pragma unroll
  for (int r = 0; r < 16; r++) ss[r] = 0.f;
  u32x4 xr[4];
  {
    const char* src = (const char*)p.out + OOFF_XTG + (size_t)(bc * 16 + g * 8 + hg * 4) * 16384;
#pragma unroll
    for (int i = 0; i < 4; i++) xr[i] = *(const u32x4*)(src + ((tid & 255) + 256 * i) * 16);
  }
  for (int hi = 0; hi < 4; hi++) {
    const int h = g * 8 + hg * 4 + hi;
    __syncthreads();
    {
      const int t = tid & 255;
      u16* dstb = XT + hg * 64 * 136;
#pragma unroll
      for (int i = 0; i < 4; i++) {
        const int id = t + 256 * i, row = id >> 4, cc = id & 15;
        *(u32x4*)(dstb + row * 136 + cc * 8) = xr[i];
        *(u32x4*)(PVB + hg * 64 * 136 + row * 136 + cc * 8) = *(const u32x4*)((const char*)PREV + (size_t)(bc * 16 + h) * 16384 + id * 16);
      }
    }
    __syncthreads();
    if (hi < 3) {
      const char* src = (const char*)p.out + OOFF_XTG + (size_t)(bc * 16 + h + 1) * 16384;
#pragma unroll
      for (int i = 0; i < 4; i++) xr[i] = *(const u32x4*)(src + ((tid & 255) + 256 * i) * 16);
    }
    const float* acs_h = acs + (hg * 4 + hi) * 128;
    const float* dts_h = dts + (hg * 4 + hi) * 128;
    const u16* xt = XT + hg * 64 * 136;
    f32x16 acc[2];
#pragma unroll
    for (int pt = 0; pt < 2; pt++)
#pragma unroll
      for (int r = 0; r < 16; r++) acc[pt][r] = 0.f;
    const uint32_t zoff0 = ((uint32_t)(tok0 + lt * 32 + 4 * hh) * 1024u + (uint32_t)(h * 64 + r32)) * 2u;
    u16 zraw[2][16];
#pragma unroll
    for (int reg = 0; reg < 16; reg++)
      zraw[0][reg] = *(const u16*)((const char*)ZS + (zoff0 + (uint32_t)(((reg & 3) + 8 * (reg >> 2)) * 2048)));
    const u16* prev_h = PVB + hg * 64 * 136;
#pragma unroll
    for (int ks = 0; ks < 8; ks++)
#pragma unroll
      for (int pt = 0; pt < 2; pt++) {
        bf16x8 bfr = *(const bf16x8*)(prev_h + (pt * 32 + r32) * 136 + ks * 16 + hh * 8);
        acc[pt] = MFMA32(*(const bf16x8*)(cfp + ks * 16), bfr, acc[pt]);
      }
#pragma unroll
    for (int reg = 0; reg < 16; reg++) {
      const float e = __expf(acs_h[lt * 32 + (reg & 3) + 8 * (reg >> 2) + 4 * hh]);
      acc[0][reg] *= e; acc[1][reg] *= e;
    }
    const int lcol = lt * 32 + r32;
    const float acs_l = acs_h[lcol];
#pragma unroll 1
    for (int st = 0; st <= lt; st++) {
      {
        f32x16 Xs;
#pragma unroll
        for (int r = 0; r < 16; r++) Xs[r] = 0.f;
#pragma unroll
        for (int ks = 0; ks < 8; ks++) {
          bf16x8 a = *(const bf16x8*)(R2 + (st * 32 + r32) * 136 + ks * 16 + hh * 8);
          Xs = MFMA32(a, *(const bf16x8*)(cfp + ks * 16), Xs);
        }
#pragma unroll
        for (int sp = 0; sp < 2; sp++) {
          __builtin_amdgcn_sched_barrier(0);
          float gv[8];
#pragma unroll
          for (int j = 0; j < 8; j++) {
            const int reg = 8 * sp + j;
            const int s = st * 32 + (reg & 3) + 8 * (reg >> 2) + 4 * hh;
            const float v = Xs[reg] * __expf(acs_l - acs_h[s]) * dts_h[s];
            gv[j] = (s <= lcol) ? v : 0.f;
          }
          u32x4 aw; aw.x = pack2(gv[0], gv[1]); aw.y = pack2(gv[2], gv[3]); aw.z = pack2(gv[4], gv[5]); aw.w = pack2(gv[6], gv[7]);
          const bf16x8 af = __builtin_bit_cast(bf16x8, aw);
#pragma unroll
          for (int pt = 0; pt < 2; pt++) {
            const u16* xp = xt + (pt * 32 + r32) * 136 + st * 32 + sp * 16 + hh * 4;
            const u32x2 lo = *(const u32x2*)xp, hi2 = *(const u32x2*)(xp + 8);
            u32x4 bw; bw.x = lo.x; bw.y = lo.y; bw.z = hi2.x; bw.w = hi2.y;
            acc[pt] = MFMA32(af, __builtin_bit_cast(bf16x8, bw), acc[pt]);
          }
        }
      }
    }
    const float dsk = p.d_skip[h];
#pragma unroll
    for (int reg = 0; reg < 16; reg++)
      zraw[1][reg] = *(const u16*)((const char*)ZS + (zoff0 + (uint32_t)(((reg & 3) + 8 * (reg >> 2)) * 2048 + 64)));
#pragma unroll
    for (int pt = 0; pt < 2; pt++)
#pragma unroll
      for (int rg = 0; rg < 4; rg++) {
        __builtin_amdgcn_sched_barrier(0);
        const u32x2 xv = *(const u32x2*)(xt + (pt * 32 + r32) * 136 + lt * 32 + 8 * rg + 4 * hh);
#pragma unroll
        for (int i = 0; i < 4; i++) {
          const int reg = rg * 4 + i;
          const int l = lt * 32 + 8 * rg + 4 * hh + i;
          const uint32_t xw = (i < 2) ? xv.x : xv.y;
          const float xval = (i & 1) ? bfhi(xw) : bflo(xw);
          const float y = acc[pt][reg] + dsk * xval;
          const float z = bf2f((uint32_t)zraw[pt][reg]);
          const float t = y * silu(z);
          ss[reg] += t * t;
          if (!dry) *(u16*)((char*)ZS + (zoff0 + (uint32_t)(((reg & 3) + 8 * (reg >> 2)) * 2048 + pt * 64))) = f2bf(t);
        }
      }
  }
#pragma unroll
  for (int reg = 0; reg < 16; reg++) {
    float v = ss[reg];
#pragma unroll
    for (int o = 1; o < 32; o <<= 1) v += __shfl_xor(v, o);
    if (r32 == 0) part[hg * 128 + lt * 32 + (reg & 3) + 8 * (reg >> 2) + 4 * hh] = v;
  }
  __syncthreads();
  if (tid < 128 && !dry) ((float*)(p.ws + OFF_RSTD))[(tok0 + tid) * 2 + g] = rsqrtf((part[tid] + part[128 + tid]) * (1.f / 512.f) + EPS);
  __syncthreads();
}

__device__ __forceinline__ void attn_item(const Params& p, char* smem, int item, float lam, bool dry, int* qctr, int* s_next) {
  const int h = 7 - (item >> 7), qb = 63 - ((item & 127) >> 1), b = item & 1, bh = b * 8 + h;
  constexpr int KVSTAGE = 64 * 136 + 128 * 72;
  u16* KV = (u16*)smem;
  float* ex = (float*)(KV + 2 * KVSTAGE);
  const int tid = threadIdx.x, lane = tid & 63, w = tid >> 6, r32 = lane & 31, hh = lane >> 5;
  const int qt = w & 3, m = w >> 2;
  const int qpos0 = qb * 128 + qt * 32, qpos = qpos0 + r32;
  const float slope2 = __builtin_amdgcn_exp2f(-(float)(h + 1)) * LOG2E;
  const u16* Qb = (const u16*)(p.ws + OFF_Q);
  const u16* Kb = (const u16*)(p.ws + OFF_K) + (size_t)(b * 8192) * 1024 + h * 128;
  const u16* Vb = (const u16*)(p.ws + OFF_VT) + (size_t)(bh * 128) * 8192;
  u32x4 rk[2], rv[2];
  auto gload = [&](int kt) {
    const int J0 = kt * 64;
#pragma unroll
    for (int i = 0; i < 2; i++) {
      const int id = tid + 512 * i;
      rk[i] = *(const u32x4*)(Kb + (size_t)(J0 + (id >> 4)) * 1024 + (id & 15) * 8);
      rv[i] = *(const u32x4*)(Vb + (size_t)(id >> 3) * 8192 + J0 + (id & 7) * 8);
    }
  };
  auto lstore = [&](int stage) {
    u16* Ks = KV + stage * KVSTAGE;
    u16* Vs = Ks + 64 * 136;
#pragma unroll
    for (int i = 0; i < 2; i++) {
      const int id = tid + 512 * i;
      *(u32x4*)(Ks + (id >> 4) * 136 + (id & 15) * 8) = rk[i];
      u32x2 v0, v1; v0.x = rv[i].x; v0.y = rv[i].y; v1.x = rv[i].z; v1.y = rv[i].w;
      u16* vd = Vs + (id >> 3) * 72 + ((id & 7) >> 1) * 16 + ((id & 1) ? 4 : 0);
      *(u32x2*)(vd) = v0;
      *(u32x2*)(vd + 8) = v1;
    }
  };
  const int nkt = 2 * qb + 2;
  gload(nkt - 1);
  bf16x8 qf[4];
  {
    const u16* qptr = Qb + (size_t)(b * 8192 + qpos) * 1024 + h * 128 + m * 64 + hh * 8;
#pragma unroll
    for (int ks = 0; ks < 4; ks++) qf[ks] = *(const bf16x8*)(qptr + ks * 16);
  }
  float bound2;
  {
    float qn2 = 0.f;
#pragma unroll
    for (int ks = 0; ks < 4; ks++) {
      const u32x4 qw = __builtin_bit_cast(u32x4, qf[ks]);
      qn2 += bflo(qw.x) * bflo(qw.x) + bfhi(qw.x) * bfhi(qw.x) + bflo(qw.y) * bflo(qw.y) + bfhi(qw.y) * bfhi(qw.y);
      qn2 += bflo(qw.z) * bflo(qw.z) + bfhi(qw.z) * bfhi(qw.z) + bflo(qw.w) * bflo(qw.w) + bfhi(qw.w) * bfhi(qw.w);
    }
    qn2 += __shfl_xor(qn2, 32);
    const float kmax2 = __uint_as_float(((const unsigned int*)(p.ws + OFF_KMAX))[bh * 2 + m]);
    bound2 = sqrtf(qn2 * kmax2) * 1.02f;
  }
  bool wdone = false, first = true, fast = false;
  f32x16 O[4];
#pragma unroll
  for (int d = 0; d < 4; d++)
#pragma unroll
    for (int r = 0; r < 16; r++) O[d][r] = 0.f;
  float mrow = -INFINITY, lsum = 0.f;
  lstore((nkt - 1) & 1);
  __syncthreads();
  if (__builtin_amdgcn_readfirstlane(threadIdx.x) >= 256) __builtin_amdgcn_s_setprio(1);
  for (int kt = nkt - 1; kt >= 0; kt--) {
    const int J0 = kt * 64;
    const u16* Ks = KV + (kt & 1) * KVSTAGE;
    const u16* Vs = Ks + 64 * 136;
    if (kt > 0) gload(kt - 1);
    if (fast && !wdone && J0 + 64 <= qpos0) {
      const float base1 = slope2 * (float)(J0 + 32 + 4 * hh - qpos) - mrow;
      const float base0 = base1 - 32.f * slope2;
      f32x16 S1, S0;
#pragma unroll
      for (int reg = 0; reg < 16; reg++) {
        const float c = (float)((reg & 3) + 8 * (reg >> 2));
        S1[reg] = fmaf(slope2, c, base1);
        S0[reg] = fmaf(slope2, c, base0);
      }
#pragma unroll
      for (int ks = 0; ks < 4; ks++) {
        const bf16x8 k1 = *(const bf16x8*)(Ks + (32 + r32) * 136 + m * 64 + ks * 16 + hh * 8);
        const bf16x8 k0 = *(const bf16x8*)(Ks + r32 * 136 + m * 64 + ks * 16 + hh * 8);
        S1 = MFMA32(k1, qf[ks], S1);
        S0 = MFMA32(k0, qf[ks], S0);
      }
      float ps = 0.f;
#pragma unroll
      for (int sub = 1; sub >= 0; sub--) {
        uint32_t pw[8];
#pragma unroll
        for (int j = 0; j < 8; j++) {
          const float p0 = __builtin_amdgcn_exp2f(sub ? S1[2 * j] : S0[2 * j]);
          const float p1 = __builtin_amdgcn_exp2f(sub ? S1[2 * j + 1] : S0[2 * j + 1]);
          ps += p0 + p1;
          pw[j] = pack2(p0, p1);
        }
        u32x4 t0, t1; t0.x = pw[0]; t0.y = pw[1]; t0.z = pw[2]; t0.w = pw[3]; t1.x = pw[4]; t1.y = pw[5]; t1.z = pw[6]; t1.w = pw[7];
        const bf16x8 pf0 = __builtin_bit_cast(bf16x8, t0), pf1 = __builtin_bit_cast(bf16x8, t1);
#pragma unroll
        for (int d = 0; d < 4; d++)
#pragma unroll
          for (int sp = 0; sp < 2; sp++) {
            const bf16x8 vfr = *(const bf16x8*)(Vs + (d * 32 + r32) * 72 + sub * 32 + sp * 16 + hh * 8);
            O[d] = MFMA32(vfr, sp ? pf1 : pf0, O[d]);
          }
      }
      lsum += ps;
    } else
#pragma unroll
    for (int sub = 1; sub >= 0; sub--) {
      const int Js = J0 + sub * 32;
      if (!wdone && Js <= qpos0 + 31) {
        const float ref = first ? 0.f : mrow;
        const float base = slope2 * (float)(Js + 4 * hh - qpos) - ref;
        f32x16 S;
#pragma unroll
        for (int reg = 0; reg < 16; reg++) S[reg] = fmaf(slope2, (float)((reg & 3) + 8 * (reg >> 2)), base);
        bf16x8 kf[4];
#pragma unroll
        for (int ks = 0; ks < 4; ks++) kf[ks] = *(const bf16x8*)(Ks + (sub * 32 + r32) * 136 + m * 64 + ks * 16 + hh * 8);
        bf16x8 vf[4][2];
#pragma unroll
        for (int d = 0; d < 4; d++)
#pragma unroll
          for (int sp = 0; sp < 2; sp++) {
            vf[d][sp] = *(const bf16x8*)(Vs + (d * 32 + r32) * 72 + sub * 32 + sp * 16 + hh * 8);
          }
#pragma unroll
        for (int ks = 0; ks < 4; ks++) S = MFMA32(kf[ks], qf[ks], S);
        if (!fast) {
          const bool diag = (Js + 31 > qpos0);
          float mx = -INFINITY;
#pragma unroll
          for (int reg = 0; reg < 16; reg++) {
            const int key = Js + (reg & 3) + 8 * (reg >> 2) + 4 * hh;
            if (diag && key > qpos) S[reg] = -INFINITY;
            mx = fmaxf(mx, S[reg]);
          }
          mx = fmaxf(mx, __shfl_xor(mx, 32));
          const float mrel = first ? mx : fmaxf(mx, 0.f);
          const float alpha = first ? 0.f : __builtin_amdgcn_exp2f(-mrel);
          if (__any(alpha != 1.f)) {
#pragma unroll
            for (int d = 0; d < 4; d++)
#pragma unroll
              for (int r = 0; r < 16; r++) O[d][r] *= alpha;
            lsum *= alpha;
          }
          mrow = ref + mrel;
#pragma unroll
          for (int reg = 0; reg < 16; reg++) S[reg] -= mrel;
          first = false;
          fast = __all(bound2 - mrow <= 100.f);
        }
        float ps = 0.f;
        uint32_t pw[8];
#pragma unroll
        for (int j = 0; j < 8; j++) {
          const float p0 = __builtin_amdgcn_exp2f(S[2 * j]), p1 = __builtin_amdgcn_exp2f(S[2 * j + 1]);
          ps += p0 + p1;
          pw[j] = pack2(p0, p1);
        }
        lsum += ps;
        u32x4 t0, t1; t0.x = pw[0]; t0.y = pw[1]; t0.z = pw[2]; t0.w = pw[3]; t1.x = pw[4]; t1.y = pw[5]; t1.z = pw[6]; t1.w = pw[7];
        const bf16x8 pf0 = __builtin_bit_cast(bf16x8, t0), pf1 = __builtin_bit_cast(bf16x8, t1);
#pragma unroll
        for (int d = 0; d < 4; d++) {
#pragma unroll
          for (int sp = 0; sp < 2; sp++) O[d] = MFMA32(vf[d][sp], sp ? pf1 : pf0, O[d]);
        }
      }
    }
    if (!wdone) wdone = __all((bound2 - slope2 * (float)(qpos - (J0 - 1)) - mrow) < -40.f);
    if (kt > 0) lstore((kt - 1) & 1);
    if (!__syncthreads_or(!wdone)) break;
  }
  __builtin_amdgcn_s_setprio(0);
  int nxt = 0;
  if (tid == 256 && qctr) nxt = atomicAdd(qctr, 1);
  u32x2 zpre[4][4];
  {
    const uint32_t zoff = ((uint32_t)(b * 8192 + qpos) * 1024u + (uint32_t)(h * 128 + 4 * hh)) * 2u;
#pragma unroll
    for (int d = 0; d < 4; d++)
#pragma unroll
      for (int rg = 0; rg < 4; rg++)
        zpre[d][rg] = (m == 0) ? *(const u32x2*)((const char*)p.ws + OFF_ZA + (zoff + (uint32_t)((d * 32 + 8 * rg) * 2))) : u32x2{0u, 0u};
  }
  lsum += __shfl_xor(lsum, 32);
  const float inv = 1.f / lsum;
  if (m == 1) {
    const float sc = inv * lam;
#pragma unroll
    for (int d = 0; d < 4; d++)
#pragma unroll
      for (int reg = 0; reg < 16; reg++)
        ex[(qt * 128 + d * 32 + (reg & 3) + 8 * (reg >> 2) + 4 * hh) * 32 + r32] = O[d][reg] * sc;
  }
  __syncthreads();
  if (m == 0 && !dry) {
    float ssq = 0.f;
#pragma unroll
    for (int d = 0; d < 4; d++)
#pragma unroll
      for (int reg = 0; reg < 16; reg++) {
        const float v = O[d][reg] * inv - ex[(qt * 128 + d * 32 + (reg & 3) + 8 * (reg >> 2) + 4 * hh) * 32 + r32];
        O[d][reg] = v; ssq += v * v;
      }
    ssq += __shfl_xor(ssq, 32);
    const float rs = rsqrtf(ssq * (1.f / 128.f) + EPS) * 0.8f;
    const size_t rowoff = (size_t)(b * 8192 + qpos) * 1024 + h * 128;
    u16* YA = (u16*)(p.ws + OFF_Q);
#pragma unroll
    for (int d = 0; d < 4; d++)
#pragma unroll
      for (int rg = 0; rg < 4; rg++) {
        const int dv0 = d * 32 + 8 * rg + 4 * hh;
        const u32x2 zv = zpre[d][rg];
        const float4 sg = *(const float4*)(p.subln_gain + dv0);
        u32x2 o;
        o.x = pack2(O[d][rg * 4 + 0] * rs * sg.x * silu(bflo(zv.x)), O[d][rg * 4 + 1] * rs * sg.y * silu(bfhi(zv.x)));
        o.y = pack2(O[d][rg * 4 + 2] * rs * sg.z * silu(bflo(zv.y)), O[d][rg * 4 + 3] * rs * sg.w * silu(bfhi(zv.y)));
        *(u32x2*)(YA + rowoff + dv0) = o;
      }
  }
  if (tid == 256 && qctr) *s_next = nxt;
  __syncthreads();
}

__device__ __forceinline__ void phase_final(const Params& p) {
  const int tid = threadIdx.x, lane = tid & 63, wid = tid >> 6;
  for (int row0 = (blockIdx.x * 8 + wid) * 8; row0 < T_; row0 += gridDim.x * 64) {
    float4 v[8][4]; float ss[8];
#pragma unroll
    for (int r = 0; r < 8; r++) {
      const float4* orow = (const float4*)(p.out + (size_t)(row0 + r) * 1024);
#pragma unroll
      for (int i = 0; i < 4; i++) v[r][i] = orow[lane + 64 * i];
    }
#pragma unroll
    for (int r = 0; r < 8; r++) {
      float t = 0.f;
#pragma unroll
      for (int i = 0; i < 4; i++) t += v[r][i].x * v[r][i].x + v[r][i].y * v[r][i].y + v[r][i].z * v[r][i].z + v[r][i].w * v[r][i].w;
      ss[r] = rsqrtf(wave_sum(t) * (1.f / 1024.f) + EPS);
    }
#pragma unroll
    for (int i = 0; i < 4; i++) {
      const float4 g = ((const float4*)p.final_gain)[lane + 64 * i];
#pragma unroll
      for (int r = 0; r < 8; r++) {
        const float rs = ss[r];
        float4 o; o.x = v[r][i].x * rs * g.x; o.y = v[r][i].y * rs * g.y; o.z = v[r][i].z * rs * g.z; o.w = v[r][i].w * rs * g.w;
        ((float4*)(p.out + (size_t)(row0 + r) * 1024))[lane + 64 * i] = o;
      }
    }
  }
}

#ifndef PROBE
#define PROBE 0
#endif
__global__ void __launch_bounds__(512) fwd_megakernel(Params p) {
  cg::grid_group grid = cg::this_grid();
  extern __shared__ __attribute__((aligned(16))) char smem[];
  __shared__ int s_item;
  __shared__ uint4 xb_words;
  if (threadIdx.x == 0) xb_words = make_uint4(0u, 0u, 0u, 0u);
  __syncthreads();
  const XcdBarrier xb = xcd_barrier_post((unsigned*)(p.ws + OFF_BAR), (volatile LAS unsigned*)&xb_words);
#define GSYNC() xcd_barrier(xb)
  if (p.out == nullptr) grid.sync();
  phase_prep(p, smem);
  GSYNC();
  if (threadIdx.x == 0) {
    unsigned* bar = (unsigned*)(p.ws + OFF_BAR);
    unsigned pre = 0u;
    for (unsigned jx = 0; jx < xb.x; ++jx) pre += xb_ld(&bar[XB_XCNT(jx)]);
    const unsigned v = pre + xb_words.z;
    xb_words.w = (gridDim.x == 256) ? ((v & 31u) * 8u + (v >> 5)) : v;
  }
  __syncthreads();
#if PROBE == 2
  phase_prep(p, smem);
  GSYNC();
  if (threadIdx.x == 0) {
    unsigned* bar = (unsigned*)(p.ws + OFF_BAR);
    unsigned pre = 0u;
    for (unsigned jx = 0; jx < xb.x; ++jx) pre += xb_ld(&bar[XB_XCNT(jx)]);
    const unsigned v = pre + xb_words.z;
    xb_words.w = (gridDim.x == 256) ? ((v & 31u) * 8u + (v >> 5)) : v;
  }
  __syncthreads();
#endif
  gemm_phase<0>(p, smem, false, (int)xb_words.w);
  GSYNC();
#if PROBE == 1
  gemm_phase<0>(p, smem, false, (int)xb_words.w);
  GSYNC();
#endif
  phase_states(p, smem);
  GSYNC();
  phase_scan(p);
  GSYNC();
#if PROBE == 3
  phase_states(p, smem);
  GSYNC();
  phase_scan(p);
  GSYNC();
#endif
#if PROBE == 7
  for (int it = blockIdx.x; it < 256; it += gridDim.x) ssd_out_item(p, smem, it, true);
#endif
#if PROBE == 6
  GSYNC(); GSYNC(); GSYNC(); GSYNC(); GSYNC(); GSYNC();
#endif
  for (int it = blockIdx.x; it < 256; it += gridDim.x) ssd_out_item(p, smem, it, false);
  {
    const int lane = threadIdx.x & 63;
    const float s1 = wave_sum(p.lq1[lane] * p.lk1[lane]);
    const float s2 = wave_sum(p.lq2[lane] * p.lk2[lane]);
    const float lam = __expf(s1) - __expf(s2) + 0.2f;
    int* ctr = (int*)(p.ws + OFF_CTR);
#if PROBE == 4
    while (true) {
      if (threadIdx.x == 0) s_item = atomicAdd(ctr + 1, 1);
      __syncthreads();
      const int item = s_item;
      __syncthreads();
      if (item >= 1024) break;
      attn_item(p, smem, item, lam, true, nullptr, nullptr);
    }
#endif
    if (threadIdx.x == 0) s_item = atomicAdd(ctr, 1);
    __syncthreads();
    int item = s_item;
    __syncthreads();
    while (item < 1024) {
      attn_item(p, smem, item, lam, false, ctr, &s_item);
      item = s_item;
    }
  }
  GSYNC();
#if PROBE == 5
  gemm_phase<1>(p, smem, true, (int)xb_words.w);
  GSYNC();
#endif
  gemm_phase<1>(p, smem, false, (int)xb_words.w);
  GSYNC();
  phase_final(p);
}

extern "C" void kernel_launch(void* const* d_in, const int* in_sizes, int n_in, void* d_out, int out_size,
                              void* d_ws, size_t ws_size, hipStream_t stream) {
  static int grid_blocks = 0;
  if (grid_blocks == 0) {
    int dev = 0, cus = 0, per_cu = 0;
    hipGetDevice(&dev);
    hipDeviceGetAttribute(&cus, hipDeviceAttributeMultiprocessorCount, dev);
    if (ws_size < WS_NEED || out_size != T_ * 1024) { fprintf(stderr, "workspace too small: %zu < %zu\n", ws_size, (size_t)WS_NEED); grid_blocks = -1; return; }
    if (hipFuncSetAttribute((const void*)fwd_megakernel, hipFuncAttributeMaxDynamicSharedMemorySize, LDS_BYTES) != hipSuccess) {
      fprintf(stderr, "hipFuncSetAttribute failed\n"); grid_blocks = -1; return;
    }
    hipOccupancyMaxActiveBlocksPerMultiprocessor(&per_cu, (const void*)fwd_megakernel, 512, LDS_BYTES);
    if (per_cu < 1) { fprintf(stderr, "occupancy query says %d blocks/CU\n", per_cu); grid_blocks = -1; return; }
    grid_blocks = cus;
  }
  if (grid_blocks < 0) return;
  Params p{};
  p.x = (const float*)d_in[0]; p.norm_gain = (const float*)d_in[1]; p.w_in = (const float*)d_in[2];
  p.conv_w = (const float*)d_in[3]; p.conv_b = (const float*)d_in[4]; p.dt_bias = (const float*)d_in[5];
  p.a_log = (const float*)d_in[6]; p.d_skip = (const float*)d_in[7]; p.ssd_norm_gain = (const float*)d_in[8];
  p.lq1 = (const float*)d_in[9]; p.lk1 = (const float*)d_in[10]; p.lq2 = (const float*)d_in[11];
  p.lk2 = (const float*)d_in[12]; p.subln_gain = (const float*)d_in[13]; p.w_out = (const float*)d_in[14];
  p.final_gain = (const float*)d_in[15];
  p.out = (float*)d_out; p.ws = (char*)d_ws;
  if (hipMemsetAsync((char*)d_ws + OFF_CTR, 0, 256 + XCD_BAR_WORDS * 4, stream) != hipSuccess) { fprintf(stderr, "memset failed\n"); return; }
  void* args[] = {&p};
  hipError_t e = hipLaunchCooperativeKernel((const void*)fwd_megakernel, dim3(grid_blocks), dim3(512), args, LDS_BYTES, stream);
  if (e != hipSuccess) fprintf(stderr, "cooperative launch failed: %s (grid %d)\n", hipGetErrorString(e), grid_blocks);
}
```

```cpp
#include <hip/hip_runtime.h>
#include <hip/hip_cooperative_groups.h>
#include <cstdio>
#include <cstdint>
#include <cstddef>
#include <type_traits>
namespace cg = cooperative_groups;

typedef unsigned short u16;
typedef short bf16x8 __attribute__((ext_vector_type(8)));
typedef float f32x16 __attribute__((ext_vector_type(16)));
typedef uint32_t u32x4 __attribute__((ext_vector_type(4)));
typedef uint32_t u32x2 __attribute__((ext_vector_type(2)));
#define MFMA32(a, b, c) __builtin_amdgcn_mfma_f32_32x32x16_bf16((a), (b), (c), 0, 0, 0)

struct Params {
  const float* x; const float* norm_gain; const float* w_in; const float* conv_w; const float* conv_b;
  const float* dt_bias; const float* a_log; const float* d_skip; const float* ssd_norm_gain;
  const float* lq1; const float* lk1; const float* lq2; const float* lk2; const float* subln_gain;
  const float* w_out; const float* final_gain;
  float* out; char* ws;
};

constexpr int T_ = 16384;
constexpr float EPS = 1e-5f;
constexpr float LOG2E = 1.4426950408889634f;
constexpr int LDS_BYTES = 150 * 1024;
constexpr int NPAD = 6784;

constexpr size_t OFF_WOUTT = 0;
constexpr size_t OFF_PREV = 4194304;
constexpr size_t OFF_ZS = OFF_PREV + 33554432;
constexpr size_t OFF_XBC = OFF_ZS + 33554432;
constexpr size_t OFF_DT = OFF_XBC + 50331648;
constexpr size_t OFF_Q = OFF_DT + 1048576;
constexpr size_t OFF_K = OFF_Q + 33554432;
constexpr size_t OFF_VT = OFF_K + 33554432;
constexpr size_t OFF_ZA = OFF_VT + 33554432;
constexpr size_t OFF_CD = OFF_ZA + 33554432;
constexpr size_t OFF_ROWSS = OFF_CD + 8192;
constexpr size_t OFF_CTR = OFF_ROWSS + 65536;
constexpr size_t OFF_KMAX = OFF_CTR + 64;
constexpr size_t OFF_BAR = OFF_CTR + 256;
constexpr size_t OFF_RSTD = OFF_BAR + 16384;
constexpr size_t WS_NEED = OFF_RSTD + 131072;
constexpr size_t OOFF_WINT = 0;
constexpr size_t OOFF_U = 16777216;
constexpr size_t OOFF_XTG = 33554432;

typedef __bf16 bf16x2_t __attribute__((ext_vector_type(2)));
typedef float f32x2_t __attribute__((ext_vector_type(2)));
__device__ __forceinline__ uint32_t pack2(float a, float b) {
  f32x2_t v; v.x = a; v.y = b;
  return __builtin_bit_cast(uint32_t, __builtin_convertvector(v, bf16x2_t));
}
__device__ __forceinline__ u16 f2bf(float f) { return (u16)(pack2(f, 0.f) & 0xFFFFu); }
__device__ __forceinline__ float bf2f(uint32_t h) { return __uint_as_float(h << 16); }
__device__ __forceinline__ float bflo(uint32_t w) { return __uint_as_float(w << 16); }
__device__ __forceinline__ float bfhi(uint32_t w) { return __uint_as_float(w & 0xFFFF0000u); }
__device__ __forceinline__ float silu(float v) { return v * __builtin_amdgcn_rcpf(1.f + __expf(-v)); }
__device__ __forceinline__ float wave_sum(float v) {
#pragma unroll
  for (int o = 32; o > 0; o >>= 1) v += __shfl_xor(v, o);
  return v;
}


#define XB_TMO      128
#define XB_XCNT(j)  (256  + 64 * (j))
#define XB_XSUB(j)  (1280 + 64 * (j))
#define XB_XGEN(j)  (2304 + 64 * (j))
#define XB_TOP      3328
#define XB_TOPGEN   3392
#define XCD_BAR_WORDS 3456
#define XB_SPIN_CAP (1u << 18)
#define LAS __attribute__((address_space(3)))
__device__ __forceinline__ unsigned xb_ld(unsigned* p)              { return __hip_atomic_load(p, __ATOMIC_RELAXED, __HIP_MEMORY_SCOPE_AGENT); }
__device__ __forceinline__ unsigned xb_add(unsigned* p, unsigned v) { return __hip_atomic_fetch_add(p, v, __ATOMIC_RELAXED, __HIP_MEMORY_SCOPE_AGENT); }
__device__ __forceinline__ unsigned xb_xcc_id() { return (unsigned)__builtin_amdgcn_s_getreg((3 << 11) | 20) & 0xFu; }
#define XB_SPIN(cond, bar) do { unsigned _sp = 0; while (cond) { __builtin_amdgcn_s_sleep(1); \
    if ((++_sp & 255u) == 0u) { if (xb_ld(&(bar)[XB_TMO])) break; if (_sp > XB_SPIN_CAP) { atomicAdd(&(bar)[XB_TMO], 1u); break; } } } } while (0)
struct XcdBarrier { unsigned* bar; unsigned x; volatile LAS unsigned* st; };
__device__ __forceinline__ XcdBarrier xcd_barrier_post(unsigned* bar, volatile LAS unsigned* st) {
  XcdBarrier b; b.bar = bar; b.x = xb_xcc_id(); b.st = st;
  if (threadIdx.x == 0) st[2] = xb_add(&bar[XB_XCNT(b.x)], 1u);
  return b;
}
__device__ __forceinline__ void xcd_barrier_complete(unsigned* bar, unsigned x, unsigned& nloc, unsigned& nx) {
  const unsigned G = gridDim.x * gridDim.y * gridDim.z;
  unsigned sum, cnt, mine, sp = 0u;
  for (;;) {
    sum = 0u; cnt = 0u; mine = 0u;
#pragma unroll
    for (unsigned j = 0; j < 16; ++j) { const unsigned c = xb_ld(&bar[XB_XCNT(j)]); sum += c; cnt += (c > 0u) ? 1u : 0u; mine = (j == x) ? c : mine; }
    if (sum == G) break;
    __builtin_amdgcn_s_sleep(1);
    if ((++sp & 255u) == 0u) { if (xb_ld(&bar[XB_TMO])) break; if (sp > XB_SPIN_CAP) { atomicAdd(&bar[XB_TMO], 1u); break; } }
  }
  nloc = mine > 0u ? mine : 1u; nx = cnt > 0u ? cnt : 1u;
}
__device__ __forceinline__ void xcd_barrier(const XcdBarrier& b) {
  asm volatile("s_waitcnt vmcnt(0)" ::: "memory");
  __syncthreads();
  if (threadIdx.x == 0) {
    unsigned* bar = b.bar;
    __builtin_amdgcn_s_waitcnt(0);
    unsigned nloc = b.st[0], nx = b.st[1];
    if (nloc == 0u) { xcd_barrier_complete(bar, b.x, nloc, nx); b.st[0] = nloc; b.st[1] = nx; }
    const unsigned old = xb_add(&bar[XB_XSUB(b.x)], 1u);
    const unsigned gen = old / nloc;
    if (old + 1u == (gen + 1u) * nloc) {
      __builtin_amdgcn_fence(__ATOMIC_RELEASE, "agent");
      asm volatile("s_waitcnt vmcnt(0)" ::: "memory");
      const unsigned og = xb_add(&bar[XB_TOP], 1u);
      const unsigned tg = og / nx;
      if (og + 1u == (tg + 1u) * nx) xb_add(&bar[XB_TOPGEN], 1u);
      else XB_SPIN(xb_ld(&bar[XB_TOPGEN]) == tg, bar);
      __builtin_amdgcn_fence(__ATOMIC_ACQUIRE, "agent");
      xb_add(&bar[XB_XGEN(b.x)], 1u);
      asm volatile("s_waitcnt vmcnt(0)" ::: "memory");
    } else {
      XB_SPIN(xb_ld(&bar[XB_XGEN(b.x)]) == gen, bar);
      __builtin_amdgcn_fence(__ATOMIC_ACQUIRE, "agent");
      asm volatile("s_waitcnt vmcnt(0)" ::: "memory");
    }
  }
  __syncthreads();
}

__device__ __forceinline__ void phase_prep(const Params& p, char* smem) {
  const int tid = threadIdx.x, lane = tid & 63, wid = tid >> 6;
  float* tile = (float*)smem;
  u16* WinT = (u16*)((char*)p.out + OOFF_WINT);
  u16* WoutT = (u16*)(p.ws + OFF_WOUTT);
  u16* U = (u16*)((char*)p.out + OOFF_U);
  constexpr int NT_IN = (NPAD / 64) * 16;
  constexpr int NT_OUT = 16 * 32;
  struct TP { const float* src; u16* dst; int src_ld, dst_ld, k0, n0src, n0dst, nvalid; };
  auto tparams = [&](int t) {
    TP q;
    if (t < NT_IN) {
      const int nt = t >> 4, kt = t & 15; q.n0dst = nt * 64; q.k0 = kt * 64;
      if (q.n0dst < 2560) { q.n0src = q.n0dst; q.nvalid = 64; }
      else if (q.n0dst < 6656) { q.n0src = q.n0dst + 16; q.nvalid = 64; }
      else if (q.n0dst == 6656) { q.n0src = 2560; q.nvalid = 16; }
      else { q.n0src = 0; q.nvalid = 0; }
      q.src = p.w_in; q.src_ld = 6672; q.dst = WinT; q.dst_ld = 1024;
    } else {
      const int tt = t - NT_IN, nt = tt >> 5, kt = tt & 31; q.n0dst = nt * 64; q.n0src = q.n0dst; q.nvalid = 64; q.k0 = kt * 64;
      q.src = p.w_out; q.src_ld = 1024; q.dst = WoutT; q.dst_ld = 2048;
    }
    return q;
  };
  float nv[8];
  auto tload = [&](const TP& q) {
#pragma unroll
    for (int i = 0; i < 8; i++) {
      const int r = (tid >> 6) + 8 * i, c = tid & 63;
      nv[i] = (c < q.nvalid) ? q.src[(size_t)(q.k0 + r) * q.src_ld + q.n0src + c] : 0.f;
      if (q.src == p.w_out && q.k0 + r < 1024) nv[i] *= p.ssd_norm_gain[q.k0 + r];
    }
  };
  if (blockIdx.x < NT_IN + NT_OUT) tload(tparams(blockIdx.x));
  for (int t = blockIdx.x; t < NT_IN + NT_OUT; t += gridDim.x) {
    const TP q = tparams(t);
#pragma unroll
    for (int i = 0; i < 8; i++) tile[((tid >> 6) + 8 * i) * 65 + (tid & 63)] = nv[i];
    __syncthreads();
    if (t + (int)gridDim.x < NT_IN + NT_OUT) tload(tparams(t + gridDim.x));
    {
      const int n = tid >> 3, kc = (tid & 7) * 8;
      u32x4 o;
      o.x = pack2(tile[(kc + 0) * 65 + n], tile[(kc + 1) * 65 + n]);
      o.y = pack2(tile[(kc + 2) * 65 + n], tile[(kc + 3) * 65 + n]);
      o.z = pack2(tile[(kc + 4) * 65 + n], tile[(kc + 5) * 65 + n]);
      o.w = pack2(tile[(kc + 6) * 65 + n], tile[(kc + 7) * 65 + n]);
      *(u32x4*)(q.dst + (size_t)(q.n0dst + n) * q.dst_ld + q.k0 + kc) = o;
    }
    __syncthreads();
  }
  for (int row0 = (blockIdx.x * 8 + wid) * 8; row0 < T_; row0 += gridDim.x * 64) {
    float4 v[8][4]; float ss[8];
#pragma unroll
    for (int r = 0; r < 8; r++) {
      const float4* xr = (const float4*)(p.x + (size_t)(row0 + r) * 1024);
#pragma unroll
      for (int i = 0; i < 4; i++) v[r][i] = xr[lane + 64 * i];
    }
#pragma unroll
    for (int r = 0; r < 8; r++) {
      float t = 0.f;
#pragma unroll
      for (int i = 0; i < 4; i++) t += v[r][i].x * v[r][i].x + v[r][i].y * v[r][i].y + v[r][i].z * v[r][i].z + v[r][i].w * v[r][i].w;
      ss[r] = rsqrtf(wave_sum(t) * (1.f / 1024.f) + EPS);
    }
#pragma unroll
    for (int i = 0; i < 4; i++) {
      const float4 g = ((const float4*)p.norm_gain)[lane + 64 * i];
#pragma unroll
      for (int r = 0; r < 8; r++) {
        const float rs = ss[r];
        u32x2 o; o.x = pack2(v[r][i].x * rs * g.x, v[r][i].y * rs * g.y); o.y = pack2(v[r][i].z * rs * g.z, v[r][i].w * rs * g.w);
        *(u32x2*)(U + (size_t)(row0 + r) * 1024 + (lane + 64 * i) * 4) = o;
      }
    }
  }
}

__device__ __forceinline__ float dpp_xor1(float v) {
  return __builtin_bit_cast(float, __builtin_amdgcn_mov_dpp(__builtin_bit_cast(int, v), 0xB1, 0xF, 0xF, true));
}

template <int MODE, int NT, bool SWP>
__device__ __forceinline__ void gemm_tile(const Params& p, char* smem, int m0, int n0) {
  constexpr int KDIM = MODE == 0 ? 1024 : 2048;
  constexpr int KT = KDIM / 64;
  constexpr int LDT = 72;
  constexpr int BROWS = 64 * NT;
  constexpr int WN = 32 * NT;
  u16* As = (u16*)smem;
  u16* Bs = As + 2 * 256 * LDT;
  const int tid = threadIdx.x, lane = tid & 63, w = tid >> 6;
  const int wm = w & 3, wn = w >> 2, r32 = lane & 31, hh = lane >> 5;
  const u16* Wt = MODE == 0 ? (const u16*)((char*)p.out + OOFF_WINT) : (const u16*)(p.ws + OFF_WOUTT);
  const u16* A0 = MODE == 0 ? (const u16*)((char*)p.out + OOFF_U) : (const u16*)(p.ws + OFF_ZS);
  const u16* A1 = (const u16*)(p.ws + OFF_Q);
  const int lrow = tid >> 3, lcc = (tid & 7) * 8;
  f32x16 acc[2][NT];
#pragma unroll
  for (int i = 0; i < 2; i++)
#pragma unroll
    for (int j = 0; j < NT; j++)
#pragma unroll
      for (int r = 0; r < 16; r++) acc[i][j][r] = 0.f;
  u32x4 ra[4], rb[NT];
  const uint32_t aoff0 = (uint32_t)(m0 + lrow) * 2048u + (uint32_t)lcc * 2u;
  const uint32_t boff0 = (uint32_t)(n0 + lrow) * (uint32_t)(KDIM * 2) + (uint32_t)lcc * 2u;
  auto gload = [&](int kt) {
    const char* abase = (const char*)((MODE == 0 || kt < 16) ? A0 : A1);
    const uint32_t ao = aoff0 + (uint32_t)(kt & 15) * 128u;
    const uint32_t bo = boff0 + (uint32_t)kt * 128u;
#pragma unroll
    for (int i = 0; i < 4; i++) ra[i] = *(const u32x4*)(abase + (ao + (uint32_t)i * (64u * 2048u)));
#pragma unroll
    for (int i = 0; i < NT; i++) rb[i] = *(const u32x4*)((const char*)Wt + (bo + (uint32_t)i * (uint32_t)(64 * KDIM * 2)));
  };
  auto lstore = [&](int buf) {
#pragma unroll
    for (int i = 0; i < 4; i++) *(u32x4*)(As + buf * 256 * LDT + (lrow + 64 * i) * LDT + lcc) = ra[i];
#pragma unroll
    for (int i = 0; i < NT; i++) *(u32x4*)(Bs + buf * 256 * LDT + (lrow + 64 * i) * LDT + lcc) = rb[i];
  };
  float rs0[2] = {1.f, 1.f}, rs1[2] = {1.f, 1.f};
  if (MODE == 1 && SWP) {
    const float* RS = (const float*)(p.ws + OFF_RSTD);
#pragma unroll
    for (int i = 0; i < 2; i++) { const float2 r = *(const float2*)(RS + (m0 + wm * 64 + i * 32 + r32) * 2); rs0[i] = r.x * __builtin_amdgcn_rcpf(r.y); rs1[i] = r.y; }
  }
  gload(0); lstore(0);
  __syncthreads();
  for (int kt = 0; kt < KT; kt++) {
    const int buf = kt & 1;
    if (kt + 1 < KT) gload(kt + 1);
    const u16* a_base = As + buf * 256 * LDT + (wm * 64 + r32) * LDT + hh * 8;
    const u16* b_base = Bs + buf * 256 * LDT + (wn * WN + r32) * LDT + hh * 8;
#pragma unroll
    for (int ks = 0; ks < 4; ks++) {
      bf16x8 af[2], bfr[NT];
#pragma unroll
      for (int i = 0; i < 2; i++) af[i] = *(const bf16x8*)(a_base + i * 32 * LDT + ks * 16);
#pragma unroll
      for (int j = 0; j < NT; j++) bfr[j] = *(const bf16x8*)(b_base + j * 32 * LDT + ks * 16);
#pragma unroll
      for (int i = 0; i < 2; i++)
#pragma unroll
        for (int j = 0; j < NT; j++) acc[i][j] = SWP ? MFMA32(bfr[j], af[i], acc[i][j]) : MFMA32(af[i], bfr[j], acc[i][j]);
      __builtin_amdgcn_sched_barrier(0);
      if (kt + 1 < KT) {
        u16* an = As + (buf ^ 1) * 256 * LDT + lrow * LDT + lcc;
        u16* bn = Bs + (buf ^ 1) * 256 * LDT + lrow * LDT + lcc;
        if (ks == 1) { *(u32x4*)(an) = ra[0]; *(u32x4*)(an + 64 * LDT) = ra[1]; *(u32x4*)(an + 128 * LDT) = ra[2]; }
        if (ks == 2) { *(u32x4*)(an + 192 * LDT) = ra[3]; *(u32x4*)(bn) = rb[0]; *(u32x4*)(bn + 64 * LDT) = rb[1]; }
        if (ks == 3 && NT == 4) { *(u32x4*)(bn + 128 * LDT) = rb[NT - 2]; *(u32x4*)(bn + 192 * LDT) = rb[NT - 1]; }
      }
    }
    if (MODE == 1 && SWP && (kt == 7 || kt == 15)) {
#pragma unroll
      for (int i = 0; i < 2; i++) {
        const float sc = (kt == 7) ? rs0[i] : rs1[i];
#pragma unroll
        for (int j = 0; j < NT; j++)
#pragma unroll
          for (int r = 0; r < 16; r++) acc[i][j][r] *= sc;
      }
    }
    __syncthreads();
  }
  if (SWP) {
    const int row0 = m0 + wm * 64 + r32;
    if (MODE == 0) {
      if (n0 == 6656) {
        if (wn == 0) {
          float* DT = (float*)(p.ws + OFF_DT);
#pragma unroll
          for (int mt = 0; mt < 2; mt++)
#pragma unroll
            for (int g = 0; g < 2; g++) {
              const int c0 = 8 * g + 4 * hh;
              const float4 bias = *(const float4*)(p.dt_bias + c0);
              float4 o;
              { const float v = acc[mt][0][4 * g + 0] + bias.x; o.x = fmaxf(v, 0.f) + log1pf(__expf(-fabsf(v))); }
              { const float v = acc[mt][0][4 * g + 1] + bias.y; o.y = fmaxf(v, 0.f) + log1pf(__expf(-fabsf(v))); }
              { const float v = acc[mt][0][4 * g + 2] + bias.z; o.z = fmaxf(v, 0.f) + log1pf(__expf(-fabsf(v))); }
              { const float v = acc[mt][0][4 * g + 3] + bias.w; o.w = fmaxf(v, 0.f) + log1pf(__expf(-fabsf(v))); }
              *(float4*)(DT + (row0 + mt * 32) * 16 + c0) = o;
            }
        }
      } else if (n0 >= 4608 && n0 < 5632) {
        u16* VT = (u16*)(p.ws + OFF_VT);
        const int q4 = lane & 3;
        const bool q1 = q4 & 1, q2 = q4 & 2;
#pragma unroll
        for (int mt = 0; mt < 2; mt++) {
          const int t0 = (row0 + mt * 32) & ~3;
          const uint32_t tb = ((uint32_t)((t0 >> 13) * 1024 + (n0 - 4608 + wn * WN + 4 * hh + q4)) * 8192u + (uint32_t)(t0 & 8191)) * 2u;
#pragma unroll
          for (int nt = 0; nt < NT; nt++)
#pragma unroll
            for (int g = 0; g < 4; g++) {
              const float a0 = acc[mt][nt][4 * g + 0], a1 = acc[mt][nt][4 * g + 1], a2 = acc[mt][nt][4 * g + 2], a3 = acc[mt][nt][4 * g + 3];
              const float r1 = dpp_xor1(q1 ? a0 : a1), r3 = dpp_xor1(q1 ? a2 : a3);
              const uint32_t p01 = q1 ? pack2(r1, a1) : pack2(a0, r1);
              const uint32_t p23 = q1 ? pack2(r3, a3) : pack2(a2, r3);
              const uint32_t rx = (uint32_t)__builtin_amdgcn_mov_dpp((int)(q2 ? p01 : p23), 0x4E, 0xF, 0xF, true);
              u32x2 o; o.x = q2 ? rx : p01; o.y = q2 ? p23 : rx;
              *(u32x2*)((char*)VT + (tb + (uint32_t)(nt * 32 + 8 * g) * 16384u)) = o;
            }
        }
      } else {
        u16* dst; int ld, coff; float scale = 1.f;
        if (n0 < 1024) { dst = (u16*)(p.ws + OFF_ZS); ld = 1024; coff = 0; }
        else if (n0 < 2560) { dst = (u16*)(p.ws + OFF_XBC); ld = 1536; coff = 1024; }
        else if (n0 < 3584) { dst = (u16*)(p.ws + OFF_Q); ld = 1024; coff = 2560; scale = 0.125f * LOG2E; }
        else if (n0 < 4608) { dst = (u16*)(p.ws + OFF_K); ld = 1024; coff = 3584; }
        else { dst = (u16*)(p.ws + OFF_ZA); ld = 1024; coff = 5632; }
#pragma unroll
        for (int mt = 0; mt < 2; mt++) {
          const uint32_t rowb = ((uint32_t)(row0 + mt * 32) * (uint32_t)ld + (uint32_t)(n0 + wn * WN - coff + (hh ? 8 : 0))) * 2u;
#pragma unroll
          for (int nt = 0; nt < NT; nt++)
#pragma unroll
            for (int k = 0; k < 4; k += 2) {
              uint32_t ax = pack2(acc[mt][nt][4 * k + 0] * scale, acc[mt][nt][4 * k + 1] * scale);
              uint32_t ay = pack2(acc[mt][nt][4 * k + 2] * scale, acc[mt][nt][4 * k + 3] * scale);
              uint32_t bx = pack2(acc[mt][nt][4 * k + 4] * scale, acc[mt][nt][4 * k + 5] * scale);
              uint32_t by = pack2(acc[mt][nt][4 * k + 6] * scale, acc[mt][nt][4 * k + 7] * scale);
              { auto r = __builtin_amdgcn_permlane32_swap(ax, bx, false, false); ax = r[0]; bx = r[1]; }
              { auto r = __builtin_amdgcn_permlane32_swap(ay, by, false, false); ay = r[0]; by = r[1]; }
              u32x4 o; o.x = ax; o.y = ay; o.z = bx; o.w = by;
              *(u32x4*)((char*)dst + (rowb + (uint32_t)((nt * 32 + 8 * k) * 2))) = o;
            }
        }
        if (n0 >= 3584 && n0 < 4608) {
#pragma unroll
          for (int grp = 0; grp < NT / 2; grp++) {
            float mx = 0.f;
#pragma unroll
            for (int mt = 0; mt < 2; mt++) {
              float v = 0.f;
#pragma unroll
              for (int reg = 0; reg < 16; reg++) v += acc[mt][2 * grp][reg] * acc[mt][2 * grp][reg] + acc[mt][2 * grp + 1][reg] * acc[mt][2 * grp + 1][reg];
              v += __shfl_xor(v, 32);
              mx = fmaxf(mx, v);
            }
#pragma unroll
            for (int o = 1; o < 32; o <<= 1) mx = fmaxf(mx, __shfl_xor(mx, o));
            if (lane == 0) atomicMax((unsigned int*)(p.ws + OFF_KMAX) + (m0 >> 13) * 16 + ((n0 - 3584 + wn * WN + grp * 64) >> 6), __float_as_uint(mx));
          }
        }
      }
    } else {
#pragma unroll
      for (int mt = 0; mt < 2; mt++) {
        const uint32_t rowb = ((uint32_t)(row0 + mt * 32) * 1024u + (uint32_t)(n0 + wn * WN + 4 * hh)) * 4u;
#pragma unroll
        for (int nt = 0; nt < NT; nt++)
#pragma unroll
          for (int g = 0; g < 4; g++) {
            const uint32_t idx = rowb + (uint32_t)((nt * 32 + 8 * g) * 4);
            const float4 xv = *(const float4*)((const char*)p.x + idx);
            float4 o;
            o.x = xv.x + acc[mt][nt][4 * g + 0]; o.y = xv.y + acc[mt][nt][4 * g + 1];
            o.z = xv.z + acc[mt][nt][4 * g + 2]; o.w = xv.w + acc[mt][nt][4 * g + 3];
            *(float4*)((char*)p.out + idx) = o;
          }
      }
    }
    return;
  }
  const int rbase = m0 + wm * 64 + 4 * hh;
  const int cbase = n0 + wn * WN + r32;
  const bool odd = lane & 1;
  if (MODE == 0) {
    if (n0 >= 4608 && n0 < 5632) {
      u16* VT = (u16*)(p.ws + OFF_VT);
#pragma unroll
      for (int mt = 0; mt < 2; mt++)
#pragma unroll
        for (int nt = 0; nt < NT; nt++)
#pragma unroll
          for (int rg = 0; rg < 4; rg++) {
            const int row0 = rbase + mt * 32 + 8 * rg;
            const int c = cbase + nt * 32 - 4608;
            const int bb = row0 >> 13, sq = row0 & 8191;
            u32x2 o; o.x = pack2(acc[mt][nt][rg * 4 + 0], acc[mt][nt][rg * 4 + 1]); o.y = pack2(acc[mt][nt][rg * 4 + 2], acc[mt][nt][rg * 4 + 3]);
            *(u32x2*)((char*)VT + ((uint32_t)(bb * 1024 + c) * 8192u + (uint32_t)sq) * 2u) = o;
          }
    } else if (NT == 2 && n0 == 6656) {
      if (wn == 0 && r32 < 16) {
        float* DT = (float*)(p.ws + OFF_DT);
        const float bias = p.dt_bias[r32];
#pragma unroll
        for (int mt = 0; mt < 2; mt++)
#pragma unroll
          for (int reg = 0; reg < 16; reg++) {
            const int row = rbase + mt * 32 + (reg & 3) + 8 * (reg >> 2);
            const float v = acc[mt][0][reg] + bias;
            DT[row * 16 + r32] = fmaxf(v, 0.f) + log1pf(__expf(-fabsf(v)));
          }
      }
    } else {
      u16* dst; int ld, coff; float scale = 1.f;
      if (n0 < 1024) { dst = (u16*)(p.ws + OFF_ZS); ld = 1024; coff = 0; }
      else if (n0 < 2560) { dst = (u16*)(p.ws + OFF_XBC); ld = 1536; coff = 1024; }
      else if (n0 < 3584) { dst = (u16*)(p.ws + OFF_Q); ld = 1024; coff = 2560; scale = 0.125f * LOG2E; }
      else if (n0 < 4608) { dst = (u16*)(p.ws + OFF_K); ld = 1024; coff = 3584; }
      else { dst = (u16*)(p.ws + OFF_ZA); ld = 1024; coff = 5632; }
#pragma unroll
      for (int mt = 0; mt < 2; mt++)
#pragma unroll
        for (int nt = 0; nt < NT; nt++)
#pragma unroll
          for (int t = 0; t < 8; t++) {
            const float va = acc[mt][nt][2 * t] * scale, vb = acc[mt][nt][2 * t + 1] * scale;
            const float recv = dpp_xor1(odd ? va : vb);
            const int reg = 2 * t + (odd ? 1 : 0);
            const int row = rbase + mt * 32 + (reg & 3) + 8 * (reg >> 2);
            const int col = ((cbase + nt * 32) & ~1) - coff;
            *(uint32_t*)((char*)dst + ((uint32_t)row * (uint32_t)ld + (uint32_t)col) * 2u) = odd ? pack2(recv, vb) : pack2(va, recv);
          }
      if (n0 >= 3584 && n0 < 4608) {
#pragma unroll
        for (int grp = 0; grp < NT / 2; grp++) {
          float mx = 0.f;
#pragma unroll
          for (int mt = 0; mt < 2; mt++)
#pragma unroll
            for (int reg = 0; reg < 16; reg++) {
              float v = acc[mt][2 * grp][reg] * acc[mt][2 * grp][reg] + acc[mt][2 * grp + 1][reg] * acc[mt][2 * grp + 1][reg];
#pragma unroll
              for (int o = 1; o < 32; o <<= 1) v += __shfl_xor(v, o);
              mx = fmaxf(mx, v);
            }
          mx = fmaxf(mx, __shfl_xor(mx, 32));
          if (lane == 0) atomicMax((unsigned int*)(p.ws + OFF_KMAX) + (m0 >> 13) * 16 + ((n0 - 3584 + wn * WN + grp * 64) >> 6), __float_as_uint(mx));
        }
      }
    }
  } else {
#pragma unroll
    for (int mt = 0; mt < 2; mt++)
#pragma unroll
      for (int nt = 0; nt < NT; nt++)
#pragma unroll
        for (int t = 0; t < 8; t++) {
          const float va = acc[mt][nt][2 * t], vb = acc[mt][nt][2 * t + 1];
          const float recv = dpp_xor1(odd ? va : vb);
          const int reg = 2 * t + (odd ? 1 : 0);
          const int row = rbase + mt * 32 + (reg & 3) + 8 * (reg >> 2);
          const int col = (cbase + nt * 32) & ~1;
          const uint32_t idx = ((uint32_t)row * 1024u + (uint32_t)col) * 4u;
          const float2 xv = *(const float2*)((const char*)p.x + idx);
          float2 o;
          o.x = xv.x + (odd ? recv : va); o.y = xv.y + (odd ? vb : recv);
          *(float2*)((char*)p.out + idx) = o;
        }
  }
}

__device__ __forceinline__ void dt_piece(const Params& p, char* smem, int m0) {
  const int tid = threadIdx.x, lane = tid & 63, w = tid >> 6, r32 = lane & 31, hh = lane >> 5;
  const u16* U = (const u16*)((const char*)p.out + OOFF_U);
  const u16* Wd = (const u16*)((const char*)p.out + OOFF_WINT) + (size_t)6656 * 1024;
  float* red = (float*)smem;
  f32x16 acc[2];
#pragma unroll
  for (int i = 0; i < 2; i++)
#pragma unroll
    for (int r = 0; r < 16; r++) acc[i][r] = 0.f;
  bf16x8 af[2][8], bfr[8];
  const int kb = w * 128 + hh * 8;
#pragma unroll
  for (int ks = 0; ks < 8; ks++) {
    bfr[ks] = *(const bf16x8*)(Wd + (size_t)r32 * 1024 + kb + ks * 16);
#pragma unroll
    for (int i = 0; i < 2; i++) af[i][ks] = *(const bf16x8*)(U + (size_t)(m0 + i * 32 + r32) * 1024 + kb + ks * 16);
  }
#pragma unroll
  for (int ks = 0; ks < 8; ks++)
#pragma unroll
    for (int i = 0; i < 2; i++) acc[i] = MFMA32(af[i][ks], bfr[ks], acc[i]);
  __syncthreads();
#pragma unroll
  for (int i = 0; i < 2; i++)
#pragma unroll
    for (int reg = 0; reg < 16; reg++)
      red[(w * 64 + i * 32 + (reg & 3) + 8 * (reg >> 2) + 4 * hh) * 32 + r32] = acc[i][reg];
  __syncthreads();
  float* DT = (float*)(p.ws + OFF_DT);
#pragma unroll
  for (int o = tid; o < 1024; o += 512) {
    const int row = o >> 4, col = o & 15;
    float v = p.dt_bias[col];
#pragma unroll
    for (int ww = 0; ww < 8; ww++) v += red[(ww * 64 + row) * 32 + col];
    DT[(m0 + row) * 16 + col] = fmaxf(v, 0.f) + log1pf(__expf(-fabsf(v)));
  }
  __syncthreads();
}

template <int MODE>
__device__ __forceinline__ void gemm_phase(const Params& p, char* smem, bool dry, int vbid) {
  (void)dry;
  const int bid = vbid;
  if (gridDim.x == 256) {
    const int x = bid & 7, j = bid >> 3;
    const int m0 = (x * 8 + (j & 7)) * 256, nq = j >> 3;
    if (MODE == 0) {
#pragma unroll 1
      for (int r = 0; r < 6; r++) {
        const int n0 = (r * 4 + nq) * 256;
        gemm_tile<0, 4, false>(p, smem, m0, n0);
      }
      gemm_tile<0, 2, false>(p, smem, m0, 6144 + nq * 128);
      dt_piece(p, smem, (int)blockIdx.x * 64);
    } else {
      gemm_tile<1, 4, true>(p, smem, m0, nq * 256);
    }
  } else {
    constexpr int NTN = MODE == 0 ? 53 : 8;
    for (int tile = bid; tile < 64 * NTN; tile += gridDim.x) {
      const int n0 = (tile >> 6) * 128;
      gemm_tile<MODE, 2, MODE == 1>(p, smem, (tile & 63) * 256, n0);
    }
  }
}

template <typename F>
__device__ __forceinline__ void conv_run32(const u16* xbc0, int col, bool first_chunk, int l0, const float* cw, const float* cb, F f) {
  const float w0 = cw[col], w1 = cw[1536 + col], w2 = cw[2 * 1536 + col], w3 = cw[3 * 1536 + col], bias = cb[col];
  float u[35];
#pragma unroll
  for (int i = 0; i < 35; i++) {
    const int l = l0 - 3 + i;
    u[i] = (first_chunk && l < 0) ? 0.f : bf2f((uint32_t)xbc0[(ptrdiff_t)l * 1536 + col]);
  }
#pragma unroll
  for (int i = 0; i < 32; i++) {
    const float v = w0 * u[i] + w1 * u[i + 1] + w2 * u[i + 2] + w3 * u[i + 3] + bias;
    f(i, silu(v));
  }
}

__device__ __forceinline__ void phase_states(const Params& p, char* smem) {
  u16* BT = (u16*)smem;
  u16* XT = BT + 128 * 136;
  float* wl = (float*)(XT + 2 * 64 * 136);
  const int tid = threadIdx.x, lane = tid & 63, w = tid >> 6, r32 = lane & 31, hh = lane >> 5;
  const int hg = w >> 2, wq = w & 3;
  const u16* XBC = (const u16*)(p.ws + OFF_XBC);
  const float* DT = (const float*)(p.ws + OFF_DT);
  float* CD = (float*)(p.ws + OFF_CD);
  u16* ST = (u16*)p.out;
  for (int item = blockIdx.x; item < 256; item += gridDim.x) {
    const int g = item & 1, bc = item >> 1, c = bc & 63, b = bc >> 6;
    const int tok0 = b * 8192 + c * 128;
    const u16* xbc0 = XBC + (size_t)tok0 * 1536;
    {
      const int h = g * 8 + w;
      const float v0 = DT[(tok0 + 2 * lane) * 16 + h], v1 = DT[(tok0 + 2 * lane + 1) * 16 + h];
      float sc = v0 + v1;
#pragma unroll
      for (int d = 1; d < 64; d <<= 1) { float t = __shfl_up(sc, d); if (lane >= d) sc += t; }
      const float A = -__expf(p.a_log[h]);
      const float tot = __shfl(sc, 63);
      const float e = sc - (v0 + v1);
      wl[w * 128 + 2 * lane] = v0 * __expf(A * (tot - (e + v0)));
      wl[w * 128 + 2 * lane + 1] = v1 * __expf(A * (tot - sc));
      if (lane == 0) CD[bc * 16 + h] = __expf(A * tot);
    }
    {
      const int ch = tid & 127, q = tid >> 7;
      u16* dst = BT + ch * 136 + q * 32;
      uint32_t pk[16];
      conv_run32(xbc0, 1024 + g * 128 + ch, c == 0, q * 32, p.conv_w, p.conv_b, [&](int i, float v) {
        const uint32_t hb = f2bf(v);
        if (i & 1) pk[i >> 1] |= hb << 16; else pk[i >> 1] = hb;
      });
#pragma unroll
      for (int j = 0; j < 4; j++) { u32x4 o; o.x = pk[4 * j]; o.y = pk[4 * j + 1]; o.z = pk[4 * j + 2]; o.w = pk[4 * j + 3]; *(u32x4*)(dst + 8 * j) = o; }
    }
    for (int hi = 0; hi < 4; hi++) {
      const int hl = hg * 4 + hi, h = g * 8 + hl;
      __syncthreads();
      {
        const int t = tid & 255, ch = t & 63, q = t >> 6;
        u16* dst = XT + hg * 64 * 136 + ch * 136 + q * 32;
        const float* wlh = wl + hl * 128 + q * 32;
        uint32_t pk[16], pg[16];
        float pv = 0.f, ps = 0.f;
        conv_run32(xbc0, h * 64 + ch, c == 0, q * 32, p.conv_w, p.conv_b, [&](int i, float v) {
          const float sc = v * wlh[i];
          if (i & 1) { pk[i >> 1] = pack2(ps, sc); pg[i >> 1] = pack2(pv, v); } else { pv = v; ps = sc; }
        });
        u16* dstg = (u16*)((char*)p.out + OOFF_XTG) + ((size_t)(bc * 16 + h) * 64 + ch) * 128 + q * 32;
#pragma unroll
        for (int j = 0; j < 4; j++) {
          u32x4 o; o.x = pk[4 * j]; o.y = pk[4 * j + 1]; o.z = pk[4 * j + 2]; o.w = pk[4 * j + 3]; *(u32x4*)(dst + 8 * j) = o;
          u32x4 og; og.x = pg[4 * j]; og.y = pg[4 * j + 1]; og.z = pg[4 * j + 2]; og.w = pg[4 * j + 3]; *(u32x4*)(dstg + 8 * j) = og;
        }
      }
      __syncthreads();
      {
        const u16* xt = XT + hg * 64 * 136;
        f32x16 acc[2];
#pragma unroll
        for (int mt = 0; mt < 2; mt++)
#pragma unroll
          for (int r = 0; r < 16; r++) acc[mt][r] = 0.f;
#pragma unroll
        for (int ks = 0; ks < 8; ks++) {
          const bf16x8 bb = *(const bf16x8*)(BT + (wq * 32 + r32) * 136 + ks * 16 + hh * 8);
#pragma unroll
          for (int mt = 0; mt < 2; mt++) {
            const bf16x8 a = *(const bf16x8*)(xt + (mt * 32 + r32) * 136 + ks * 16 + hh * 8);
            acc[mt] = MFMA32(a, bb, acc[mt]);
          }
        }
        u16* dst = ST + ((size_t)(bc * 16 + h) * 64) * 128;
#pragma unroll
        for (int mt = 0; mt < 2; mt++)
#pragma unroll
          for (int reg = 0; reg < 16; reg++) {
            const int pp = mt * 32 + (reg & 3) + 8 * (reg >> 2) + 4 * hh;
            dst[pp * 128 + wq * 32 + r32] = f2bf(acc[mt][reg]);
          }
      }
    }
    __syncthreads();
  }
}

__device__ __forceinline__ void phase_scan(const Params& p) {
  const u16* ST = (const u16*)p.out;
  const float* CD = (const float*)(p.ws + OFF_CD);
  u16* PREV = (u16*)(p.ws + OFF_PREV);
  for (int idx = blockIdx.x * 512 + threadIdx.x; idx < 131072; idx += gridDim.x * 512) {
    const int e = idx * 2;
    const int b = e >> 17, rem = e & 131071, h = rem >> 13;
    float hx = 0.f, hy = 0.f;
#pragma unroll 32
    for (int c = 0; c < 64; c++) {
      const size_t off = (size_t)(b * 64 + c) * 131072 + rem;
      const uint32_t sw = *(const uint32_t*)(ST + off);
      float2 s; s.x = bflo(sw); s.y = bfhi(sw);
      const float d = CD[(b * 64 + c) * 16 + h];
      *(uint32_t*)(PREV + off) = pack2(hx, hy);
      hx = hx * d + s.x; hy = hy * d + s.y;
    }
  }
}

__device__ __forceinline__ void ssd_out_item(const Params& p, char* smem, int item, bool dry) {
  const int g = item & 1, bc = item >> 1, c = bc & 63, b = bc >> 6;
  const int tok0 = b * 8192 + c * 128;
  u16* R1 = (u16*)smem;
  u16* R2 = R1 + 128 * 136;
  u16* XT = R2 + 128 * 136;
  float* dts = (float*)(XT + 2 * 64 * 136);
  float* acs = dts + 1024;
  float* part = acs + 1024;
  float* rstd = part + 256;
  u16* PVB = (u16*)(rstd + 128);
  const int tid = threadIdx.x, lane = tid & 63, w = tid >> 6, r32 = lane & 31, hh = lane >> 5;
  const int lt = w & 3, hg = w >> 2;
  const u16* xbc0 = (const u16*)(p.ws + OFF_XBC) + (size_t)tok0 * 1536;
  const float* DT = (const float*)(p.ws + OFF_DT);
  u16* ZS = (u16*)(p.ws + OFF_ZS);
  const u16* PREV = (const u16*)(p.ws + OFF_PREV);
  const bool first = (c == 0);
  {
    const int h = g * 8 + w;
    const float v0 = DT[(tok0 + 2 * lane) * 16 + h], v1 = DT[(tok0 + 2 * lane + 1) * 16 + h];
    float sc = v0 + v1;
#pragma unroll
    for (int d = 1; d < 64; d <<= 1) { float t = __shfl_up(sc, d); if (lane >= d) sc += t; }
    const float A = -__expf(p.a_log[h]);
    const float e = sc - (v0 + v1);
    dts[w * 128 + 2 * lane] = v0; dts[w * 128 + 2 * lane + 1] = v1;
    acs[w * 128 + 2 * lane] = A * (e + v0); acs[w * 128 + 2 * lane + 1] = A * sc;
  }
  {
    const int ch = tid & 127, q = tid >> 7;
    conv_run32(xbc0, 1280 + g * 128 + ch, first, q * 32, p.conv_w, p.conv_b, [&](int i, float v) { R1[(q * 32 + i) * 136 + ch] = f2bf(v); });
    conv_run32(xbc0, 1024 + g * 128 + ch, first, q * 32, p.conv_w, p.conv_b, [&](int i, float v) { R2[(q * 32 + i) * 136 + ch] = f2bf(v); });
  }
  __syncthreads();
  const u16* cfp = R1 + (lt * 32 + r32) * 136 + hh * 8;
  float ss[16];
#pragma unroll
  for (int r = 0; r < 16; r++) ss[r] = 0.f;
  u32x4 xr[4];
  {
    const char* src = (const char*)p.out + OOFF_XTG + (size_t)(bc * 16 + g * 8 + hg * 4) * 16384;
#pragma unroll
    for (int i = 0; i < 4; i++) xr[i] = *(const u32x4*)(src + ((tid & 255) + 256 * i) * 16);
  }
  for (int hi = 0; hi < 4; hi++) {
    const int h = g * 8 + hg * 4 + hi;
    __syncthreads();
    {
      const int t = tid & 255;
      u16* dstb = XT + hg * 64 * 136;
#pragma unroll
      for (int i = 0; i < 4; i++) {
        const int id = t + 256 * i, row = id >> 4, cc = id & 15;
        *(u32x4*)(dstb + row * 136 + cc * 8) = xr[i];
        *(u32x4*)(PVB + hg * 64 * 136 + row * 136 + cc * 8) = *(const u32x4*)((const char*)PREV + (size_t)(bc * 16 + h) * 16384 + id * 16);
      }
    }
    __syncthreads();
    if (hi < 3) {
      const char* src = (const char*)p.out + OOFF_XTG + (size_t)(bc * 16 + h + 1) * 16384;
#pragma unroll
      for (int i = 0; i < 4; i++) xr[i] = *(const u32x4*)(src + ((tid & 255) + 256 * i) * 16);
    }
    const float* acs_h = acs + (hg * 4 + hi) * 128;
    const float* dts_h = dts + (hg * 4 + hi) * 128;
    const u16* xt = XT + hg * 64 * 136;
    f32x16 acc[2];
#pragma unroll
    for (int pt = 0; pt < 2; pt++)
#pragma unroll
      for (int r = 0; r < 16; r++) acc[pt][r] = 0.f;
    const uint32_t zoff0 = ((uint32_t)(tok0 + lt * 32 + 4 * hh) * 1024u + (uint32_t)(h * 64 + r32)) * 2u;
    u16 zraw[2][16];
#pragma unroll
    for (int reg = 0; reg < 16; reg++)
      zraw[0][reg] = *(const u16*)((const char*)ZS + (zoff0 + (uint32_t)(((reg & 3) + 8 * (reg >> 2)) * 2048)));
    const u16* prev_h = PVB + hg * 64 * 136;
#pragma unroll
    for (int ks = 0; ks < 8; ks++)
#pragma unroll
      for (int pt = 0; pt < 2; pt++) {
        bf16x8 bfr = *(const bf16x8*)(prev_h + (pt * 32 + r32) * 136 + ks * 16 + hh * 8);
        acc[pt] = MFMA32(*(const bf16x8*)(cfp + ks * 16), bfr, acc[pt]);
      }
#pragma unroll
    for (int reg = 0; reg < 16; reg++) {
      const float e = __expf(acs_h[lt * 32 + (reg & 3) + 8 * (reg >> 2) + 4 * hh]);
      acc[0][reg] *= e; acc[1][reg] *= e;
    }
    const int lcol = lt * 32 + r32;
    const float acs_l = acs_h[lcol];
#pragma unroll 1
    for (int st = 0; st <= lt; st++) {
      {
        f32x16 Xs;
#pragma unroll
        for (int r = 0; r < 16; r++) Xs[r] = 0.f;
#pragma unroll
        for (int ks = 0; ks < 8; ks++) {
          bf16x8 a = *(const bf16x8*)(R2 + (st * 32 + r32) * 136 + ks * 16 + hh * 8);
          Xs = MFMA32(a, *(const bf16x8*)(cfp + ks * 16), Xs);
        }
#pragma unroll
        for (int sp = 0; sp < 2; sp++) {
          __builtin_amdgcn_sched_barrier(0);
          float gv[8];
#pragma unroll
          for (int j = 0; j < 8; j++) {
            const int reg = 8 * sp + j;
            const int s = st * 32 + (reg & 3) + 8 * (reg >> 2) + 4 * hh;
            const float v = Xs[reg] * __expf(acs_l - acs_h[s]) * dts_h[s];
            gv[j] = (s <= lcol) ? v : 0.f;
          }
          u32x4 aw; aw.x = pack2(gv[0], gv[1]); aw.y = pack2(gv[2], gv[3]); aw.z = pack2(gv[4], gv[5]); aw.w = pack2(gv[6], gv[7]);
          const bf16x8 af = __builtin_bit_cast(bf16x8, aw);
#pragma unroll
          for (int pt = 0; pt < 2; pt++) {
            const u16* xp = xt + (pt * 32 + r32) * 136 + st * 32 + sp * 16 + hh * 4;
            const u32x2 lo = *(const u32x2*)xp, hi2 = *(const u32x2*)(xp + 8);
            u32x4 bw; bw.x = lo.x; bw.y = lo.y; bw.z = hi2.x; bw.w = hi2.y;
            acc[pt] = MFMA32(af, __builtin_bit_cast(bf16x8, bw), acc[pt]);
          }
        }
      }
    }
    const float dsk = p.d_skip[h];
#pragma unroll
    for (int reg = 0; reg < 16; reg++)
      zraw[1][reg] = *(const u16*)((const char*)ZS + (zoff0 + (uint32_t)(((reg & 3) + 8 * (reg >> 2)) * 2048 + 64)));
#pragma unroll
    for (int pt = 0; pt < 2; pt++)
#pragma unroll
      for (int rg = 0; rg < 4; rg++) {
        __builtin_amdgcn_sched_barrier(0);
        const u32x2 xv = *(const u32x2*)(xt + (pt * 32 + r32) * 136 + lt * 32 + 8 * rg + 4 * hh);
#pragma unroll
        for (int i = 0; i < 4; i++) {
          const int reg = rg * 4 + i;
          const int l = lt * 32 + 8 * rg + 4 * hh + i;
          const uint32_t xw = (i < 2) ? xv.x : xv.y;
          const float xval = (i & 1) ? bfhi(xw) : bflo(xw);
          const float y = acc[pt][reg] + dsk * xval;
          const float z = bf2f((uint32_t)zraw[pt][reg]);
          const float t = y * silu(z);
          ss[reg] += t * t;
          if (!dry) *(u16*)((char*)ZS + (zoff0 + (uint32_t)(((reg & 3) + 8 * (reg >> 2)) * 2048 + pt * 64))) = f2bf(t);
        }
      }
  }
#pragma unroll
  for (int reg = 0; reg < 16; reg++) {
    float v = ss[reg];
#pragma unroll
    for (int o = 1; o < 32; o <<= 1) v += __shfl_xor(v, o);
    if (r32 == 0) part[hg * 128 + lt * 32 + (reg & 3) + 8 * (reg >> 2) + 4 * hh] = v;
  }
  __syncthreads();
  if (tid < 128 && !dry) ((float*)(p.ws + OFF_RSTD))[(tok0 + tid) * 2 + g] = rsqrtf((part[tid] + part[128 + tid]) * (1.f / 512.f) + EPS);
  __syncthreads();
}

__device__ __forceinline__ void attn_item(const Params& p, char* smem, int item, float lam, bool dry, int* qctr, int* s_next) {
  const int h = 7 - (item >> 7), qb = 63 - ((item & 127) >> 1), b = item & 1, bh = b * 8 + h;
  constexpr int KVSTAGE = 64 * 136 + 128 * 72;
  u16* KV = (u16*)smem;
  float* ex = (float*)(KV + 2 * KVSTAGE);
  const int tid = threadIdx.x, lane = tid & 63, w = tid >> 6, r32 = lane & 31, hh = lane >> 5;
  const int qt = w & 3, m = w >> 2;
  const int qpos0 = qb * 128 + qt * 32, qpos = qpos0 + r32;
  const float slope2 = __builtin_amdgcn_exp2f(-(float)(h + 1)) * LOG2E;
  const u16* Qb = (const u16*)(p.ws + OFF_Q);
  const u16* Kb = (const u16*)(p.ws + OFF_K) + (size_t)(b * 8192) * 1024 + h * 128;
  const u16* Vb = (const u16*)(p.ws + OFF_VT) + (size_t)(bh * 128) * 8192;
  u32x4 rk[2], rv[2];
  auto gload = [&](int kt) {
    const int J0 = kt * 64;
#pragma unroll
    for (int i = 0; i < 2; i++) {
      const int id = tid + 512 * i;
      rk[i] = *(const u32x4*)(Kb + (size_t)(J0 + (id >> 4)) * 1024 + (id & 15) * 8);
      rv[i] = *(const u32x4*)(Vb + (size_t)(id >> 3) * 8192 + J0 + (id & 7) * 8);
    }
  };
  auto lstore = [&](int stage) {
    u16* Ks = KV + stage * KVSTAGE;
    u16* Vs = Ks + 64 * 136;
#pragma unroll
    for (int i = 0; i < 2; i++) {
      const int id = tid + 512 * i;
      *(u32x4*)(Ks + (id >> 4) * 136 + (id & 15) * 8) = rk[i];
      u32x2 v0, v1; v0.x = rv[i].x; v0.y = rv[i].y; v1.x = rv[i].z; v1.y = rv[i].w;
      u16* vd = Vs + (id >> 3) * 72 + ((id & 7) >> 1) * 16 + ((id & 1) ? 4 : 0);
      *(u32x2*)(vd) = v0;
      *(u32x2*)(vd + 8) = v1;
    }
  };
  const int nkt = 2 * qb + 2;
  gload(nkt - 1);
  bf16x8 qf[4];
  {
    const u16* qptr = Qb + (size_t)(b * 8192 + qpos) * 1024 + h * 128 + m * 64 + hh * 8;
#pragma unroll
    for (int ks = 0; ks < 4; ks++) qf[ks] = *(const bf16x8*)(qptr + ks * 16);
  }
  float bound2;
  {
    float qn2 = 0.f;
#pragma unroll
    for (int ks = 0; ks < 4; ks++) {
      const u32x4 qw = __builtin_bit_cast(u32x4, qf[ks]);
      qn2 += bflo(qw.x) * bflo(qw.x) + bfhi(qw.x) * bfhi(qw.x) + bflo(qw.y) * bflo(qw.y) + bfhi(qw.y) * bfhi(qw.y);
      qn2 += bflo(qw.z) * bflo(qw.z) + bfhi(qw.z) * bfhi(qw.z) + bflo(qw.w) * bflo(qw.w) + bfhi(qw.w) * bfhi(qw.w);
    }
    qn2 += __shfl_xor(qn2, 32);
    const float kmax2 = __uint_as_float(((const unsigned int*)(p.ws + OFF_KMAX))[bh * 2 + m]);
    bound2 = sqrtf(qn2 * kmax2) * 1.02f;
  }
  bool wdone = false, first = true, fast = false;
  f32x16 O[4];
#pragma unroll
  for (int d = 0; d < 4; d++)
#pragma unroll
    for (int r = 0; r < 16; r++) O[d][r] = 0.f;
  float mrow = -INFINITY, lsum = 0.f;
  lstore((nkt - 1) & 1);
  __syncthreads();
  if (__builtin_amdgcn_readfirstlane(threadIdx.x) >= 256) __builtin_amdgcn_s_setprio(1);
  for (int kt = nkt - 1; kt >= 0; kt--) {
    const int J0 = kt * 64;
    const u16* Ks = KV + (kt & 1) * KVSTAGE;
    const u16* Vs = Ks + 64 * 136;
    if (kt > 0) gload(kt - 1);
    if (fast && !wdone && J0 + 64 <= qpos0) {
      const float base1 = slope2 * (float)(J0 + 32 + 4 * hh - qpos) - mrow;
      const float base0 = base1 - 32.f * slope2;
      f32x16 S1, S0;
#pragma unroll
      for (int reg = 0; reg < 16; reg++) {
        const float c = (float)((reg & 3) + 8 * (reg >> 2));
        S1[reg] = fmaf(slope2, c, base1);
        S0[reg] = fmaf(slope2, c, base0);
      }
#pragma unroll
      for (int ks = 0; ks < 4; ks++) {
        const bf16x8 k1 = *(const bf16x8*)(Ks + (32 + r32) * 136 + m * 64 + ks * 16 + hh * 8);
        const bf16x8 k0 = *(const bf16x8*)(Ks + r32 * 136 + m * 64 + ks * 16 + hh * 8);
        S1 = MFMA32(k1, qf[ks], S1);
        S0 = MFMA32(k0, qf[ks], S0);
      }
      float ps = 0.f;
#pragma unroll
      for (int sub = 1; sub >= 0; sub--) {
        uint32_t pw[8];
#pragma unroll
        for (int j = 0; j < 8; j++) {
          const float p0 = __builtin_amdgcn_exp2f(sub ? S1[2 * j] : S0[2 * j]);
          const float p1 = __builtin_amdgcn_exp2f(sub ? S1[2 * j + 1] : S0[2 * j + 1]);
          ps += p0 + p1;
          pw[j] = pack2(p0, p1);
        }
        u32x4 t0, t1; t0.x = pw[0]; t0.y = pw[1]; t0.z = pw[2]; t0.w = pw[3]; t1.x = pw[4]; t1.y = pw[5]; t1.z = pw[6]; t1.w = pw[7];
        const bf16x8 pf0 = __builtin_bit_cast(bf16x8, t0), pf1 = __builtin_bit_cast(bf16x8, t1);
#pragma unroll
        for (int d = 0; d < 4; d++)
#pragma unroll
          for (int sp = 0; sp < 2; sp++) {
            const bf16x8 vfr = *(const bf16x8*)(Vs + (d * 32 + r32) * 72 + sub * 32 + sp * 16 + hh * 8);
            O[d] = MFMA32(vfr, sp ? pf1 : pf0, O[d]);
          }
      }
      lsum += ps;
    } else
#pragma unroll
    for (int sub = 1; sub >= 0; sub--) {
      const int Js = J0 + sub * 32;
      if (!wdone && Js <= qpos0 + 31) {
        const float ref = first ? 0.f : mrow;
        const float base = slope2 * (float)(Js + 4 * hh - qpos) - ref;
        f32x16 S;
#pragma unroll
        for (int reg = 0; reg < 16; reg++) S[reg] = fmaf(slope2, (float)((reg & 3) + 8 * (reg >> 2)), base);
        bf16x8 kf[4];
#pragma unroll
        for (int ks = 0; ks < 4; ks++) kf[ks] = *(const bf16x8*)(Ks + (sub * 32 + r32) * 136 + m * 64 + ks * 16 + hh * 8);
        bf16x8 vf[4][2];
#pragma unroll
        for (int d = 0; d < 4; d++)
#pragma unroll
          for (int sp = 0; sp < 2; sp++) {
            vf[d][sp] = *(const bf16x8*)(Vs + (d * 32 + r32) * 72 + sub * 32 + sp * 16 + hh * 8);
          }
#pragma unroll
        for (int ks = 0; ks < 4; ks++) S = MFMA32(kf[ks], qf[ks], S);
        if (!fast) {
          const bool diag = (Js + 31 > qpos0);
          float mx = -INFINITY;
#pragma unroll
          for (int reg = 0; reg < 16; reg++) {
            const int key = Js + (reg & 3) + 8 * (reg >> 2) + 4 * hh;
            if (diag && key > qpos) S[reg] = -INFINITY;
            mx = fmaxf(mx, S[reg]);
          }
          mx = fmaxf(mx, __shfl_xor(mx, 32));
          const float mrel = first ? mx : fmaxf(mx, 0.f);
          const float alpha = first ? 0.f : __builtin_amdgcn_exp2f(-mrel);
          if (__any(alpha != 1.f)) {
#pragma unroll
            for (int d = 0; d < 4; d++)
#pragma unroll
              for (int r = 0; r < 16; r++) O[d][r] *= alpha;
            lsum *= alpha;
          }
          mrow = ref + mrel;
#pragma unroll
          for (int reg = 0; reg < 16; reg++) S[reg] -= mrel;
          first = false;
          fast = __all(bound2 - mrow <= 100.f);
        }
        float ps = 0.f;
        uint32_t pw[8];
#pragma unroll
        for (int j = 0; j < 8; j++) {
          const float p0 = __builtin_amdgcn_exp2f(S[2 * j]), p1 = __builtin_amdgcn_exp2f(S[2 * j + 1]);
          ps += p0 + p1;
          pw[j] = pack2(p0, p1);
        }
        lsum += ps;
        u32x4 t0, t1; t0.x = pw[0]; t0.y = pw[1]; t0.z = pw[2]; t0.w = pw[3]; t1.x = pw[4]; t1.y = pw[5]; t1.z = pw[6]; t1.w = pw[7];
        const bf16x8 pf0 = __builtin_bit_cast(bf16x8, t0), pf1 = __builtin_bit_cast(bf16x8, t1);
#pragma unroll
        for (int d = 0; d < 4; d++) {
#pragma unroll
          for (int sp = 0; sp < 2; sp++) O[d] = MFMA32(vf[d][sp], sp ? pf1 : pf0, O[d]);
        }
      }
    }
    if (!wdone) wdone = __all((bound2 - slope2 * (float)(qpos - (J0 - 1)) - mrow) < -40.f);
    if (kt > 0) lstore((kt - 1) & 1);
    if (!__syncthreads_or(!wdone)) break;
  }
  __builtin_amdgcn_s_setprio(0);
  int nxt = 0;
  if (tid == 256 && qctr) nxt = atomicAdd(qctr, 1);
  u32x2 zpre[4][4];
  {
    const uint32_t zoff = ((uint32_t)(b * 8192 + qpos) * 1024u + (uint32_t)(h * 128 + 4 * hh)) * 2u;
#pragma unroll
    for (int d = 0; d < 4; d++)
#pragma unroll
      for (int rg = 0; rg < 4; rg++)
        zpre[d][rg] = (m == 0) ? *(const u32x2*)((const char*)p.ws + OFF_ZA + (zoff + (uint32_t)((d * 32 + 8 * rg) * 2))) : u32x2{0u, 0u};
  }
  lsum += __shfl_xor(lsum, 32);
  const float inv = 1.f / lsum;
  if (m == 1) {
    const float sc = inv * lam;
#pragma unroll
    for (int d = 0; d < 4; d++)
#pragma unroll
      for (int reg = 0; reg < 16; reg++)
        ex[(qt * 128 + d * 32 + (reg & 3) + 8 * (reg >> 2) + 4 * hh) * 32 + r32] = O[d][reg] * sc;
  }
  __syncthreads();
  if (m == 0 && !dry) {
    float ssq = 0.f;
#pragma unroll
    for (int d = 0; d < 4; d++)
#pragma unroll
      for (int reg = 0; reg < 16; reg++) {
        const float v = O[d][reg] * inv - ex[(qt * 128 + d * 32 + (reg & 3) + 8 * (reg >> 2) + 4 * hh) * 32 + r32];
        O[d][reg] = v; ssq += v * v;
      }
    ssq += __shfl_xor(ssq, 32);
    const float rs = rsqrtf(ssq * (1.f / 128.f) + EPS) * 0.8f;
    const size_t rowoff = (size_t)(b * 8192 + qpos) * 1024 + h * 128;
    u16* YA = (u16*)(p.ws + OFF_Q);
#pragma unroll
    for (int d = 0; d < 4; d++)
#pragma unroll
      for (int rg = 0; rg < 4; rg++) {
        const int dv0 = d * 32 + 8 * rg + 4 * hh;
        const u32x2 zv = zpre[d][rg];
        const float4 sg = *(const float4*)(p.subln_gain + dv0);
        u32x2 o;
        o.x = pack2(O[d][rg * 4 + 0] * rs * sg.x * silu(bflo(zv.x)), O[d][rg * 4 + 1] * rs * sg.y * silu(bfhi(zv.x)));
        o.y = pack2(O[d][rg * 4 + 2] * rs * sg.z * silu(bflo(zv.y)), O[d][rg * 4 + 3] * rs * sg.w * silu(bfhi(zv.y)));
        *(u32x2*)(YA + rowoff + dv0) = o;
      }
  }
  if (tid == 256 && qctr) *s_next = nxt;
  __syncthreads();
}

__device__ __forceinline__ void phase_final(const Params& p) {
  const int tid = threadIdx.x, lane = tid & 63, wid = tid >> 6;
  for (int row0 = (blockIdx.x * 8 + wid) * 8; row0 < T_; row0 += gridDim.x * 64) {
    float4 v[8][4]; float ss[8];
#pragma unroll
    for (int r = 0; r < 8; r++) {
      const float4* orow = (const float4*)(p.out + (size_t)(row0 + r) * 1024);
#pragma unroll
      for (int i = 0; i < 4; i++) v[r][i] = orow[lane + 64 * i];
    }
#pragma unroll
    for (int r = 0; r < 8; r++) {
      float t = 0.f;
#pragma unroll
      for (int i = 0; i < 4; i++) t += v[r][i].x * v[r][i].x + v[r][i].y * v[r][i].y + v[r][i].z * v[r][i].z + v[r][i].w * v[r][i].w;
      ss[r] = rsqrtf(wave_sum(t) * (1.f / 1024.f) + EPS);
    }
#pragma unroll
    for (int i = 0; i < 4; i++) {
      const float4 g = ((const float4*)p.final_gain)[lane + 64 * i];
#pragma unroll
      for (int r = 0; r < 8; r++) {
        const float rs = ss[r];
        float4 o; o.x = v[r][i].x * rs * g.x; o.y = v[r][i].y * rs * g.y; o.z = v[r][i].z * rs * g.z; o.w = v[r][i].w * rs * g.w;
        { typedef float f4v __attribute__((ext_vector_type(4))); f4v ov; ov.x = o.x; ov.y = o.y; ov.z = o.z; ov.w = o.w;
          __builtin_nontemporal_store(ov, (f4v*)(p.out + (size_t)(row0 + r) * 1024) + (lane + 64 * i)); }
      }
    }
  }
}

#ifndef PROBE
#define PROBE 0
#endif
__global__ void __launch_bounds__(512) fwd_megakernel(Params p) {
  cg::grid_group grid = cg::this_grid();
  extern __shared__ __attribute__((aligned(16))) char smem[];
  __shared__ int s_item;
  __shared__ uint4 xb_words;
  if (threadIdx.x == 0) xb_words = make_uint4(0u, 0u, 0u, 0u);
  __syncthreads();
  const XcdBarrier xb = xcd_barrier_post((unsigned*)(p.ws + OFF_BAR), (volatile LAS unsigned*)&xb_words);
#define GSYNC() xcd_barrier(xb)
  if (p.out == nullptr) grid.sync();
  phase_prep(p, smem);
  GSYNC();
  if (threadIdx.x == 0) {
    unsigned* bar = (unsigned*)(p.ws + OFF_BAR);
    unsigned pre = 0u;
    for (unsigned jx = 0; jx < xb.x; ++jx) pre += xb_ld(&bar[XB_XCNT(jx)]);
    const unsigned v = pre + xb_words.z;
    xb_words.w = (gridDim.x == 256) ? ((v & 31u) * 8u + (v >> 5)) : v;
  }
  __syncthreads();
#if PROBE == 2
  phase_prep(p, smem);
  GSYNC();
  if (threadIdx.x == 0) {
    unsigned* bar = (unsigned*)(p.ws + OFF_BAR);
    unsigned pre = 0u;
    for (unsigned jx = 0; jx < xb.x; ++jx) pre += xb_ld(&bar[XB_XCNT(jx)]);
    const unsigned v = pre + xb_words.z;
    xb_words.w = (gridDim.x == 256) ? ((v & 31u) * 8u + (v >> 5)) : v;
  }
  __syncthreads();
#endif
  gemm_phase<0>(p, smem, false, (int)xb_words.w);
  GSYNC();
#if PROBE == 1
  gemm_phase<0>(p, smem, false, (int)xb_words.w);
  GSYNC();
#endif
  phase_states(p, smem);
  GSYNC();
  phase_scan(p);
  GSYNC();
#if PROBE == 3
  phase_states(p, smem);
  GSYNC();
  phase_scan(p);
  GSYNC();
#endif
#if PROBE == 7
  for (int it = blockIdx.x; it < 256; it += gridDim.x) ssd_out_item(p, smem, it, true);
#endif
#if PROBE == 6
  GSYNC(); GSYNC(); GSYNC(); GSYNC(); GSYNC(); GSYNC();
#endif
  for (int it = blockIdx.x; it < 256; it += gridDim.x) ssd_out_item(p, smem, it, false);
  {
    const int lane = threadIdx.x & 63;
    const float s1 = wave_sum(p.lq1[lane] * p.lk1[lane]);
    const float s2 = wave_sum(p.lq2[lane] * p.lk2[lane]);
    const float lam = __expf(s1) - __expf(s2) + 0.2f;
    int* ctr = (int*)(p.ws + OFF_CTR);
#if PROBE == 4
    while (true) {
      if (threadIdx.x == 0) s_item = atomicAdd(ctr + 1, 1);
      __syncthreads();
      const int item = s_item;
      __syncthreads();
      if (item >= 1024) break;
      attn_item(p, smem, item, lam, true, nullptr, nullptr);
    }
#endif
    if (threadIdx.x == 0) s_item = atomicAdd(ctr, 1);
    __syncthreads();
    int item = s_item;
    __syncthreads();
    while (item < 1024) {
      attn_item(p, smem, item, lam, false, ctr, &s_item);
      item = s_item;
    }
  }
  GSYNC();
#if PROBE == 5
  gemm_phase<1>(p, smem, true, (int)xb_words.w);
  GSYNC();
#endif
  gemm_phase<1>(p, smem, false, (int)xb_words.w);
  GSYNC();
  phase_final(p);
}

extern "C" void kernel_launch(void* const* d_in, const int* in_sizes, int n_in, void* d_out, int out_size,
                              void* d_ws, size_t ws_size, hipStream_t stream) {
  static int grid_blocks = 0;
  if (grid_blocks == 0) {
    int dev = 0, cus = 0, per_cu = 0;
    hipGetDevice(&dev);
    hipDeviceGetAttribute(&cus, hipDeviceAttributeMultiprocessorCount, dev);
    if (ws_size < WS_NEED || out_size != T_ * 1024) { fprintf(stderr, "workspace too small: %zu < %zu\n", ws_size, (size_t)WS_NEED); grid_blocks = -1; return; }
    if (hipFuncSetAttribute((const void*)fwd_megakernel, hipFuncAttributeMaxDynamicSharedMemorySize, LDS_BYTES) != hipSuccess) {
      fprintf(stderr, "hipFuncSetAttribute failed\n"); grid_blocks = -1; return;
    }
    hipOccupancyMaxActiveBlocksPerMultiprocessor(&per_cu, (const void*)fwd_megakernel, 512, LDS_BYTES);
    if (per_cu < 1) { fprintf(stderr, "occupancy query says %d blocks/CU\n", per_cu); grid_blocks = -1; return; }
    grid_blocks = cus;
  }
  if (grid_blocks < 0) return;
  Params p{};
  p.x = (const float*)d_in[0]; p.norm_gain = (const float*)d_in[1]; p.w_in = (const float*)d_in[2];
  p.conv_w = (const float*)d_in[3]; p.conv_b = (const float*)d_in[4]; p.dt_bias = (const float*)d_in[5];
  p.a_log = (const float*)d_in[6]; p.d_skip = (const float*)d_in[7]; p.ssd_norm_gain = (const float*)d_in[8];
  p.lq1 = (const float*)d_in[9]; p.lk1 = (const float*)d_in[10]; p.lq2 = (const float*)d_in[11];
  p.lk2 = (const float*)d_in[12]; p.subln_gain = (const float*)d_in[13]; p.w_out = (const float*)d_in[14];
  p.final_gain = (const float*)d_in[15];
  p.out = (float*)d_out; p.ws = (char*)d_ws;
  if (hipMemsetAsync((char*)d_ws + OFF_CTR, 0, 256 + XCD_BAR_WORDS * 4, stream) != hipSuccess) { fprintf(stderr, "memset failed\n"); return; }
  void* args[] = {&p};
  hipError_t e = hipLaunchCooperativeKernel((const void*)fwd_megakernel, dim3(grid_blocks), dim3(512), args, LDS_BYTES, stream);
  if (e != hipSuccess) fprintf(stderr, "cooperative launch failed: %s (grid %d)\n", hipGetErrorString(e), grid_blocks);
}
```

```cpp
#include <hip/hip_runtime.h>
#include <hip/hip_cooperative_groups.h>
#include <cstdio>
#include <cstdint>
#include <cstddef>
#include <type_traits>
namespace cg = cooperative_groups;

typedef unsigned short u16;
typedef short bf16x8 __attribute__((ext_vector_type(8)));
typedef float f32x16 __attribute__((ext_vector_type(16)));
typedef uint32_t u32x4 __attribute__((ext_vector_type(4)));
typedef uint32_t u32x2 __attribute__((ext_vector_type(2)));
#define MFMA32(a, b, c) __builtin_amdgcn_mfma_f32_32x32x16_bf16((a), (b), (c), 0, 0, 0)

struct Params {
  const float* x; const float* norm_gain; const float* w_in; const float* conv_w; const float* conv_b;
  const float* dt_bias; const float* a_log; const float* d_skip; const float* ssd_norm_gain;
  const float* lq1; const float* lk1; const float* lq2; const float* lk2; const float* subln_gain;
  const float* w_out; const float* final_gain;
  float* out; char* ws;
};

constexpr int T_ = 16384;
constexpr float EPS = 1e-5f;
constexpr float LOG2E = 1.4426950408889634f;
constexpr int LDS_BYTES = 150 * 1024;
constexpr int NPAD = 6784;

constexpr size_t OFF_WOUTT = 0;
constexpr size_t OFF_PREV = 4194304;
constexpr size_t OFF_ZS = OFF_PREV + 33554432;
constexpr size_t OFF_XBC = OFF_ZS + 33554432;
constexpr size_t OFF_DT = OFF_XBC + 50331648;
constexpr size_t OFF_Q = OFF_DT + 1048576;
constexpr size_t OFF_K = OFF_Q + 33554432;
constexpr size_t OFF_VT = OFF_K + 33554432;
constexpr size_t OFF_ZA = OFF_VT + 33554432;
constexpr size_t OFF_CD = OFF_ZA + 33554432;
constexpr size_t OFF_ROWSS = OFF_CD + 8192;
constexpr size_t OFF_CTR = OFF_ROWSS + 65536;
constexpr size_t OFF_KMAX = OFF_CTR + 64;
constexpr size_t OFF_BAR = OFF_CTR + 256;
constexpr size_t OFF_RSTD = OFF_BAR + 16384;
constexpr size_t WS_NEED = OFF_RSTD + 131072;
constexpr size_t OOFF_WINT = 0;
constexpr size_t OOFF_U = 16777216;
constexpr size_t OOFF_XTG = 33554432;

typedef __bf16 bf16x2_t __attribute__((ext_vector_type(2)));
typedef float f32x2_t __attribute__((ext_vector_type(2)));
__device__ __forceinline__ uint32_t pack2(float a, float b) {
  f32x2_t v; v.x = a; v.y = b;
  return __builtin_bit_cast(uint32_t, __builtin_convertvector(v, bf16x2_t));
}
__device__ __forceinline__ u16 f2bf(float f) { return (u16)(pack2(f, 0.f) & 0xFFFFu); }
__device__ __forceinline__ float bf2f(uint32_t h) { return __uint_as_float(h << 16); }
__device__ __forceinline__ float bflo(uint32_t w) { return __uint_as_float(w << 16); }
__device__ __forceinline__ float bfhi(uint32_t w) { return __uint_as_float(w & 0xFFFF0000u); }
__device__ __forceinline__ float silu(float v) { return v * __builtin_amdgcn_rcpf(1.f + __expf(-v)); }
__device__ __forceinline__ float wave_sum(float v) {
#pragma unroll
  for (int o = 32; o > 0; o >>= 1) v += __shfl_xor(v, o);
  return v;
}


#define XB_TMO      128
#define XB_XCNT(j)  (256  + 64 * (j))
#define XB_XSUB(j)  (1280 + 64 * (j))
#define XB_XGEN(j)  (2304 + 64 * (j))
#define XB_TOP      3328
#define XB_TOPGEN   3392
#define XCD_BAR_WORDS 3456
#define XB_SPIN_CAP (1u << 18)
#define LAS __attribute__((address_space(3)))
__device__ __forceinline__ unsigned xb_ld(unsigned* p)              { return __hip_atomic_load(p, __ATOMIC_RELAXED, __HIP_MEMORY_SCOPE_AGENT); }
__device__ __forceinline__ unsigned xb_add(unsigned* p, unsigned v) { return __hip_atomic_fetch_add(p, v, __ATOMIC_RELAXED, __HIP_MEMORY_SCOPE_AGENT); }
__device__ __forceinline__ unsigned xb_xcc_id() { return (unsigned)__builtin_amdgcn_s_getreg((3 << 11) | 20) & 0xFu; }
#define XB_SPIN(cond, bar) do { unsigned _sp = 0; while (cond) { __builtin_amdgcn_s_sleep(1); \
    if ((++_sp & 255u) == 0u) { if (xb_ld(&(bar)[XB_TMO])) break; if (_sp > XB_SPIN_CAP) { atomicAdd(&(bar)[XB_TMO], 1u); break; } } } } while (0)
struct XcdBarrier { unsigned* bar; unsigned x; volatile LAS unsigned* st; };
__device__ __forceinline__ XcdBarrier xcd_barrier_post(unsigned* bar, volatile LAS unsigned* st) {
  XcdBarrier b; b.bar = bar; b.x = xb_xcc_id(); b.st = st;
  if (threadIdx.x == 0) st[2] = xb_add(&bar[XB_XCNT(b.x)], 1u);
  return b;
}
__device__ __forceinline__ void xcd_barrier_complete(unsigned* bar, unsigned x, unsigned& nloc, unsigned& nx) {
  const unsigned G = gridDim.x * gridDim.y * gridDim.z;
  unsigned sum, cnt, mine, sp = 0u;
  for (;;) {
    sum = 0u; cnt = 0u; mine = 0u;
#pragma unroll
    for (unsigned j = 0; j < 16; ++j) { const unsigned c = xb_ld(&bar[XB_XCNT(j)]); sum += c; cnt += (c > 0u) ? 1u : 0u; mine = (j == x) ? c : mine; }
    if (sum == G) break;
    __builtin_amdgcn_s_sleep(1);
    if ((++sp & 255u) == 0u) { if (xb_ld(&bar[XB_TMO])) break; if (sp > XB_SPIN_CAP) { atomicAdd(&bar[XB_TMO], 1u); break; } }
  }
  nloc = mine > 0u ? mine : 1u; nx = cnt > 0u ? cnt : 1u;
}
__device__ __forceinline__ void xcd_barrier(const XcdBarrier& b) {
  asm volatile("s_waitcnt vmcnt(0)" ::: "memory");
  __syncthreads();
  if (threadIdx.x == 0) {
    unsigned* bar = b.bar;
    __builtin_amdgcn_s_waitcnt(0);
    unsigned nloc = b.st[0], nx = b.st[1];
    if (nloc == 0u) { xcd_barrier_complete(bar, b.x, nloc, nx); b.st[0] = nloc; b.st[1] = nx; }
    const unsigned old = xb_add(&bar[XB_XSUB(b.x)], 1u);
    const unsigned gen = old / nloc;
    if (old + 1u == (gen + 1u) * nloc) {
      __builtin_amdgcn_fence(__ATOMIC_RELEASE, "agent");
      asm volatile("s_waitcnt vmcnt(0)" ::: "memory");
      const unsigned og = xb_add(&bar[XB_TOP], 1u);
      const unsigned tg = og / nx;
      if (og + 1u == (tg + 1u) * nx) xb_add(&bar[XB_TOPGEN], 1u);
      else XB_SPIN(xb_ld(&bar[XB_TOPGEN]) == tg, bar);
      __builtin_amdgcn_fence(__ATOMIC_ACQUIRE, "agent");
      xb_add(&bar[XB_XGEN(b.x)], 1u);
      asm volatile("s_waitcnt vmcnt(0)" ::: "memory");
    } else {
      XB_SPIN(xb_ld(&bar[XB_XGEN(b.x)]) == gen, bar);
      __builtin_amdgcn_fence(__ATOMIC_ACQUIRE, "agent");
      asm volatile("s_waitcnt vmcnt(0)" ::: "memory");
    }
  }
  __syncthreads();
}

__device__ __forceinline__ void phase_prep(const Params& p, char* smem) {
  const int tid = threadIdx.x, lane = tid & 63, wid = tid >> 6;
  float* tile = (float*)smem;
  u16* WinT = (u16*)((char*)p.out + OOFF_WINT);
  u16* WoutT = (u16*)(p.ws + OFF_WOUTT);
  u16* U = (u16*)((char*)p.out + OOFF_U);
  constexpr int NT_IN = (NPAD / 64) * 16;
  constexpr int NT_OUT = 16 * 32;
  struct TP { const float* src; u16* dst; int src_ld, dst_ld, k0, n0src, n0dst, nvalid; };
  auto tparams = [&](int t) {
    TP q;
    if (t < NT_IN) {
      const int nt = t >> 4, kt = t & 15; q.n0dst = nt * 64; q.k0 = kt * 64;
      if (q.n0dst < 2560) { q.n0src = q.n0dst; q.nvalid = 64; }
      else if (q.n0dst < 6656) { q.n0src = q.n0dst + 16; q.nvalid = 64; }
      else if (q.n0dst == 6656) { q.n0src = 2560; q.nvalid = 16; }
      else { q.n0src = 0; q.nvalid = 0; }
      q.src = p.w_in; q.src_ld = 6672; q.dst = WinT; q.dst_ld = 1024;
    } else {
      const int tt = t - NT_IN, nt = tt >> 5, kt = tt & 31; q.n0dst = nt * 64; q.n0src = q.n0dst; q.nvalid = 64; q.k0 = kt * 64;
      q.src = p.w_out; q.src_ld = 1024; q.dst = WoutT; q.dst_ld = 2048;
    }
    return q;
  };
  float nv[8];
  auto tload = [&](const TP& q) {
#pragma unroll
    for (int i = 0; i < 8; i++) {
      const int r = (tid >> 6) + 8 * i, c = tid & 63;
      nv[i] = (c < q.nvalid) ? q.src[(size_t)(q.k0 + r) * q.src_ld + q.n0src + c] : 0.f;
      if (q.src == p.w_out && q.k0 + r < 1024) nv[i] *= p.ssd_norm_gain[q.k0 + r];
    }
  };
  if (blockIdx.x < NT_IN + NT_OUT) tload(tparams(blockIdx.x));
  for (int t = blockIdx.x; t < NT_IN + NT_OUT; t += gridDim.x) {
    const TP q = tparams(t);
#pragma unroll
    for (int i = 0; i < 8; i++) tile[((tid >> 6) + 8 * i) * 65 + (tid & 63)] = nv[i];
    __syncthreads();
    if (t + (int)gridDim.x < NT_IN + NT_OUT) tload(tparams(t + gridDim.x));
    {
      const int n = tid >> 3, kc = (tid & 7) * 8;
      u32x4 o;
      o.x = pack2(tile[(kc + 0) * 65 + n], tile[(kc + 1) * 65 + n]);
      o.y = pack2(tile[(kc + 2) * 65 + n], tile[(kc + 3) * 65 + n]);
      o.z = pack2(tile[(kc + 4) * 65 + n], tile[(kc + 5) * 65 + n]);
      o.w = pack2(tile[(kc + 6) * 65 + n], tile[(kc + 7) * 65 + n]);
      *(u32x4*)(q.dst + (size_t)(q.n0dst + n) * q.dst_ld + q.k0 + kc) = o;
    }
    __syncthreads();
  }
  for (int row0 = (blockIdx.x * 8 + wid) * 8; row0 < T_; row0 += gridDim.x * 64) {
    float4 v[8][4]; float ss[8];
#pragma unroll
    for (int r = 0; r < 8; r++) {
      const float4* xr = (const float4*)(p.x + (size_t)(row0 + r) * 1024);
#pragma unroll
      for (int i = 0; i < 4; i++) v[r][i] = xr[lane + 64 * i];
    }
#pragma unroll
    for (int r = 0; r < 8; r++) {
      float t = 0.f;
#pragma unroll
      for (int i = 0; i < 4; i++) t += v[r][i].x * v[r][i].x + v[r][i].y * v[r][i].y + v[r][i].z * v[r][i].z + v[r][i].w * v[r][i].w;
      ss[r] = rsqrtf(wave_sum(t) * (1.f / 1024.f) + EPS);
    }
#pragma unroll
    for (int i = 0; i < 4; i++) {
      const float4 g = ((const float4*)p.norm_gain)[lane + 64 * i];
#pragma unroll
      for (int r = 0; r < 8; r++) {
        const float rs = ss[r];
        u32x2 o; o.x = pack2(v[r][i].x * rs * g.x, v[r][i].y * rs * g.y); o.y = pack2(v[r][i].z * rs * g.z, v[r][i].w * rs * g.w);
        *(u32x2*)(U + (size_t)(row0 + r) * 1024 + (lane + 64 * i) * 4) = o;
      }
    }
  }
}

__device__ __forceinline__ float dpp_xor1(float v) {
  return __builtin_bit_cast(float, __builtin_amdgcn_mov_dpp(__builtin_bit_cast(int, v), 0xB1, 0xF, 0xF, true));
}

template <int MODE, int NT, bool SWP>
__device__ __forceinline__ void gemm_tile(const Params& p, char* smem, int m0, int n0) {
  constexpr int KDIM = MODE == 0 ? 1024 : 2048;
  constexpr int KT = KDIM / 64;
  constexpr int LDT = 72;
  constexpr int BROWS = 64 * NT;
  constexpr int WN = 32 * NT;
  u16* As = (u16*)smem;
  u16* Bs = As + 2 * 256 * LDT;
  const int tid = threadIdx.x, lane = tid & 63, w = tid >> 6;
  const int wm = w & 3, wn = w >> 2, r32 = lane & 31, hh = lane >> 5;
  const u16* Wt = MODE == 0 ? (const u16*)((char*)p.out + OOFF_WINT) : (const u16*)(p.ws + OFF_WOUTT);
  const u16* A0 = MODE == 0 ? (const u16*)((char*)p.out + OOFF_U) : (const u16*)(p.ws + OFF_ZS);
  const u16* A1 = (const u16*)(p.ws + OFF_Q);
  const int lrow = tid >> 3, lcc = (tid & 7) * 8;
  f32x16 acc[2][NT];
#pragma unroll
  for (int i = 0; i < 2; i++)
#pragma unroll
    for (int j = 0; j < NT; j++)
#pragma unroll
      for (int r = 0; r < 16; r++) acc[i][j][r] = 0.f;
  u32x4 ra[4], rb[NT];
  const uint32_t aoff0 = (uint32_t)(m0 + lrow) * 2048u + (uint32_t)lcc * 2u;
  const uint32_t boff0 = (uint32_t)(n0 + lrow) * (uint32_t)(KDIM * 2) + (uint32_t)lcc * 2u;
  auto gload = [&](int kt) {
    const char* abase = (const char*)((MODE == 0 || kt < 16) ? A0 : A1);
    const uint32_t ao = aoff0 + (uint32_t)(kt & 15) * 128u;
    const uint32_t bo = boff0 + (uint32_t)kt * 128u;
#pragma unroll
    for (int i = 0; i < 4; i++) ra[i] = *(const u32x4*)(abase + (ao + (uint32_t)i * (64u * 2048u)));
#pragma unroll
    for (int i = 0; i < NT; i++) rb[i] = *(const u32x4*)((const char*)Wt + (bo + (uint32_t)i * (uint32_t)(64 * KDIM * 2)));
  };
  auto lstore = [&](int buf) {
#pragma unroll
    for (int i = 0; i < 4; i++) *(u32x4*)(As + buf * 256 * LDT + (lrow + 64 * i) * LDT + lcc) = ra[i];
#pragma unroll
    for (int i = 0; i < NT; i++) *(u32x4*)(Bs + buf * 256 * LDT + (lrow + 64 * i) * LDT + lcc) = rb[i];
  };
  float rs0[2] = {1.f, 1.f}, rs1[2] = {1.f, 1.f};
  if (MODE == 1 && SWP) {
    const float* RS = (const float*)(p.ws + OFF_RSTD);
#pragma unroll
    for (int i = 0; i < 2; i++) { const float2 r = *(const float2*)(RS + (m0 + wm * 64 + i * 32 + r32) * 2); rs0[i] = r.x * __builtin_amdgcn_rcpf(r.y); rs1[i] = r.y; }
  }
  gload(0); lstore(0);
  __syncthreads();
  for (int kt = 0; kt < KT; kt++) {
    const int buf = kt & 1;
    if (kt + 1 < KT) gload(kt + 1);
    const u16* a_base = As + buf * 256 * LDT + (wm * 64 + r32) * LDT + hh * 8;
    const u16* b_base = Bs + buf * 256 * LDT + (wn * WN + r32) * LDT + hh * 8;
#pragma unroll
    for (int ks = 0; ks < 4; ks++) {
      bf16x8 af[2], bfr[NT];
#pragma unroll
      for (int i = 0; i < 2; i++) af[i] = *(const bf16x8*)(a_base + i * 32 * LDT + ks * 16);
#pragma unroll
      for (int j = 0; j < NT; j++) bfr[j] = *(const bf16x8*)(b_base + j * 32 * LDT + ks * 16);
#pragma unroll
      for (int i = 0; i < 2; i++)
#pragma unroll
        for (int j = 0; j < NT; j++) acc[i][j] = SWP ? MFMA32(bfr[j], af[i], acc[i][j]) : MFMA32(af[i], bfr[j], acc[i][j]);
      __builtin_amdgcn_sched_barrier(0);
      if (kt + 1 < KT) {
        u16* an = As + (buf ^ 1) * 256 * LDT + lrow * LDT + lcc;
        u16* bn = Bs + (buf ^ 1) * 256 * LDT + lrow * LDT + lcc;
        if (ks == 1) { *(u32x4*)(an) = ra[0]; *(u32x4*)(an + 64 * LDT) = ra[1]; *(u32x4*)(an + 128 * LDT) = ra[2]; }
        if (ks == 2) { *(u32x4*)(an + 192 * LDT) = ra[3]; *(u32x4*)(bn) = rb[0]; *(u32x4*)(bn + 64 * LDT) = rb[1]; }
        if (ks == 3 && NT == 4) { *(u32x4*)(bn + 128 * LDT) = rb[NT - 2]; *(u32x4*)(bn + 192 * LDT) = rb[NT - 1]; }
      }
    }
    if (MODE == 1 && SWP && (kt == 7 || kt == 15)) {
#pragma unroll
      for (int i = 0; i < 2; i++) {
        const float sc = (kt == 7) ? rs0[i] : rs1[i];
#pragma unroll
        for (int j = 0; j < NT; j++)
#pragma unroll
          for (int r = 0; r < 16; r++) acc[i][j][r] *= sc;
      }
    }
    __syncthreads();
  }
  if (SWP) {
    const int row0 = m0 + wm * 64 + r32;
    if (MODE == 0) {
      if (n0 == 6656) {
        if (wn == 0) {
          float* DT = (float*)(p.ws + OFF_DT);
#pragma unroll
          for (int mt = 0; mt < 2; mt++)
#pragma unroll
            for (int g = 0; g < 2; g++) {
              const int c0 = 8 * g + 4 * hh;
              const float4 bias = *(const float4*)(p.dt_bias + c0);
              float4 o;
              { const float v = acc[mt][0][4 * g + 0] + bias.x; o.x = fmaxf(v, 0.f) + log1pf(__expf(-fabsf(v))); }
              { const float v = acc[mt][0][4 * g + 1] + bias.y; o.y = fmaxf(v, 0.f) + log1pf(__expf(-fabsf(v))); }
              { const float v = acc[mt][0][4 * g + 2] + bias.z; o.z = fmaxf(v, 0.f) + log1pf(__expf(-fabsf(v))); }
              { const float v = acc[mt][0][4 * g + 3] + bias.w; o.w = fmaxf(v, 0.f) + log1pf(__expf(-fabsf(v))); }
              *(float4*)(DT + (row0 + mt * 32) * 16 + c0) = o;
            }
        }
      } else if (n0 >= 4608 && n0 < 5632) {
        u16* VT = (u16*)(p.ws + OFF_VT);
        const int q4 = lane & 3;
        const bool q1 = q4 & 1, q2 = q4 & 2;
#pragma unroll
        for (int mt = 0; mt < 2; mt++) {
          const int t0 = (row0 + mt * 32) & ~3;
          const uint32_t tb = ((uint32_t)((t0 >> 13) * 1024 + (n0 - 4608 + wn * WN + 4 * hh + q4)) * 8192u + (uint32_t)(t0 & 8191)) * 2u;
#pragma unroll
          for (int nt = 0; nt < NT; nt++)
#pragma unroll
            for (int g = 0; g < 4; g++) {
              const float a0 = acc[mt][nt][4 * g + 0], a1 = acc[mt][nt][4 * g + 1], a2 = acc[mt][nt][4 * g + 2], a3 = acc[mt][nt][4 * g + 3];
              const float r1 = dpp_xor1(q1 ? a0 : a1), r3 = dpp_xor1(q1 ? a2 : a3);
              const uint32_t p01 = q1 ? pack2(r1, a1) : pack2(a0, r1);
              const uint32_t p23 = q1 ? pack2(r3, a3) : pack2(a2, r3);
              const uint32_t rx = (uint32_t)__builtin_amdgcn_mov_dpp((int)(q2 ? p01 : p23), 0x4E, 0xF, 0xF, true);
              u32x2 o; o.x = q2 ? rx : p01; o.y = q2 ? p23 : rx;
              *(u32x2*)((char*)VT + (tb + (uint32_t)(nt * 32 + 8 * g) * 16384u)) = o;
            }
        }
      } else {
        u16* dst; int ld, coff; float scale = 1.f;
        if (n0 < 1024) { dst = (u16*)(p.ws + OFF_ZS); ld = 1024; coff = 0; }
        else if (n0 < 2560) { dst = (u16*)(p.ws + OFF_XBC); ld = 1536; coff = 1024; }
        else if (n0 < 3584) { dst = (u16*)(p.ws + OFF_Q); ld = 1024; coff = 2560; scale = 0.125f * LOG2E; }
        else if (n0 < 4608) { dst = (u16*)(p.ws + OFF_K); ld = 1024; coff = 3584; }
        else { dst = (u16*)(p.ws + OFF_ZA); ld = 1024; coff = 5632; }
#pragma unroll
        for (int mt = 0; mt < 2; mt++) {
          const uint32_t rowb = ((uint32_t)(row0 + mt * 32) * (uint32_t)ld + (uint32_t)(n0 + wn * WN - coff + (hh ? 8 : 0))) * 2u;
#pragma unroll
          for (int nt = 0; nt < NT; nt++)
#pragma unroll
            for (int k = 0; k < 4; k += 2) {
              uint32_t ax = pack2(acc[mt][nt][4 * k + 0] * scale, acc[mt][nt][4 * k + 1] * scale);
              uint32_t ay = pack2(acc[mt][nt][4 * k + 2] * scale, acc[mt][nt][4 * k + 3] * scale);
              uint32_t bx = pack2(acc[mt][nt][4 * k + 4] * scale, acc[mt][nt][4 * k + 5] * scale);
              uint32_t by = pack2(acc[mt][nt][4 * k + 6] * scale, acc[mt][nt][4 * k + 7] * scale);
              { auto r = __builtin_amdgcn_permlane32_swap(ax, bx, false, false); ax = r[0]; bx = r[1]; }
              { auto r = __builtin_amdgcn_permlane32_swap(ay, by, false, false); ay = r[0]; by = r[1]; }
              u32x4 o; o.x = ax; o.y = ay; o.z = bx; o.w = by;
              *(u32x4*)((char*)dst + (rowb + (uint32_t)((nt * 32 + 8 * k) * 2))) = o;
            }
        }
        if (n0 >= 3584 && n0 < 4608) {
#pragma unroll
          for (int grp = 0; grp < NT / 2; grp++) {
            float mx = 0.f;
#pragma unroll
            for (int mt = 0; mt < 2; mt++) {
              float v = 0.f;
#pragma unroll
              for (int reg = 0; reg < 16; reg++) v += acc[mt][2 * grp][reg] * acc[mt][2 * grp][reg] + acc[mt][2 * grp + 1][reg] * acc[mt][2 * grp + 1][reg];
              v += __shfl_xor(v, 32);
              mx = fmaxf(mx, v);
            }
#pragma unroll
            for (int o = 1; o < 32; o <<= 1) mx = fmaxf(mx, __shfl_xor(mx, o));
            if (lane == 0) atomicMax((unsigned int*)(p.ws + OFF_KMAX) + (m0 >> 13) * 16 + ((n0 - 3584 + wn * WN + grp * 64) >> 6), __float_as_uint(mx));
          }
        }
      }
    } else {
#pragma unroll
      for (int mt = 0; mt < 2; mt++) {
        const uint32_t rowb = ((uint32_t)(row0 + mt * 32) * 1024u + (uint32_t)(n0 + wn * WN + 4 * hh)) * 4u;
#pragma unroll
        for (int nt = 0; nt < NT; nt++)
#pragma unroll
          for (int g = 0; g < 4; g++) {
            const uint32_t idx = rowb + (uint32_t)((nt * 32 + 8 * g) * 4);
            const float4 xv = *(const float4*)((const char*)p.x + idx);
            float4 o;
            o.x = xv.x + acc[mt][nt][4 * g + 0]; o.y = xv.y + acc[mt][nt][4 * g + 1];
            o.z = xv.z + acc[mt][nt][4 * g + 2]; o.w = xv.w + acc[mt][nt][4 * g + 3];
            *(float4*)((char*)p.out + idx) = o;
          }
      }
    }
    return;
  }
  const int rbase = m0 + wm * 64 + 4 * hh;
  const int cbase = n0 + wn * WN + r32;
  const bool odd = lane & 1;
  if (MODE == 0) {
    if (n0 >= 4608 && n0 < 5632) {
      u16* VT = (u16*)(p.ws + OFF_VT);
#pragma unroll
      for (int mt = 0; mt < 2; mt++)
#pragma unroll
        for (int nt = 0; nt < NT; nt++)
#pragma unroll
          for (int rg = 0; rg < 4; rg++) {
            const int row0 = rbase + mt * 32 + 8 * rg;
            const int c = cbase + nt * 32 - 4608;
            const int bb = row0 >> 13, sq = row0 & 8191;
            u32x2 o; o.x = pack2(acc[mt][nt][rg * 4 + 0], acc[mt][nt][rg * 4 + 1]); o.y = pack2(acc[mt][nt][rg * 4 + 2], acc[mt][nt][rg * 4 + 3]);
            *(u32x2*)((char*)VT + ((uint32_t)(bb * 1024 + c) * 8192u + (uint32_t)sq) * 2u) = o;
          }
    } else if (NT == 2 && n0 == 6656) {
      if (wn == 0 && r32 < 16) {
        float* DT = (float*)(p.ws + OFF_DT);
        const float bias = p.dt_bias[r32];
#pragma unroll
        for (int mt = 0; mt < 2; mt++)
#pragma unroll
          for (int reg = 0; reg < 16; reg++) {
            const int row = rbase + mt * 32 + (reg & 3) + 8 * (reg >> 2);
            const float v = acc[mt][0][reg] + bias;
            DT[row * 16 + r32] = fmaxf(v, 0.f) + log1pf(__expf(-fabsf(v)));
          }
      }
    } else {
      u16* dst; int ld, coff; float scale = 1.f;
      if (n0 < 1024) { dst = (u16*)(p.ws + OFF_ZS); ld = 1024; coff = 0; }
      else if (n0 < 2560) { dst = (u16*)(p.ws + OFF_XBC); ld = 1536; coff = 1024; }
      else if (n0 < 3584) { dst = (u16*)(p.ws + OFF_Q); ld = 1024; coff = 2560; scale = 0.125f * LOG2E; }
      else if (n0 < 4608) { dst = (u16*)(p.ws + OFF_K); ld = 1024; coff = 3584; }
      else { dst = (u16*)(p.ws + OFF_ZA); ld = 1024; coff = 5632; }
#pragma unroll
      for (int mt = 0; mt < 2; mt++)
#pragma unroll
        for (int nt = 0; nt < NT; nt++)
#pragma unroll
          for (int t = 0; t < 8; t++) {
            const float va = acc[mt][nt][2 * t] * scale, vb = acc[mt][nt][2 * t + 1] * scale;
            const float recv = dpp_xor1(odd ? va : vb);
            const int reg = 2 * t + (odd ? 1 : 0);
            const int row = rbase + mt * 32 + (reg & 3) + 8 * (reg >> 2);
            const int col = ((cbase + nt * 32) & ~1) - coff;
            *(uint32_t*)((char*)dst + ((uint32_t)row * (uint32_t)ld + (uint32_t)col) * 2u) = odd ? pack2(recv, vb) : pack2(va, recv);
          }
      if (n0 >= 3584 && n0 < 4608) {
#pragma unroll
        for (int grp = 0; grp < NT / 2; grp++) {
          float mx = 0.f;
#pragma unroll
          for (int mt = 0; mt < 2; mt++)
#pragma unroll
            for (int reg = 0; reg < 16; reg++) {
              float v = acc[mt][2 * grp][reg] * acc[mt][2 * grp][reg] + acc[mt][2 * grp + 1][reg] * acc[mt][2 * grp + 1][reg];
#pragma unroll
              for (int o = 1; o < 32; o <<= 1) v += __shfl_xor(v, o);
              mx = fmaxf(mx, v);
            }
          mx = fmaxf(mx, __shfl_xor(mx, 32));
          if (lane == 0) atomicMax((unsigned int*)(p.ws + OFF_KMAX) + (m0 >> 13) * 16 + ((n0 - 3584 + wn * WN + grp * 64) >> 6), __float_as_uint(mx));
        }
      }
    }
  } else {
#pragma unroll
    for (int mt = 0; mt < 2; mt++)
#pragma unroll
      for (int nt = 0; nt < NT; nt++)
#pragma unroll
        for (int t = 0; t < 8; t++) {
          const float va = acc[mt][nt][2 * t], vb = acc[mt][nt][2 * t + 1];
          const float recv = dpp_xor1(odd ? va : vb);
          const int reg = 2 * t + (odd ? 1 : 0);
          const int row = rbase + mt * 32 + (reg & 3) + 8 * (reg >> 2);
          const int col = (cbase + nt * 32) & ~1;
          const uint32_t idx = ((uint32_t)row * 1024u + (uint32_t)col) * 4u;
          const float2 xv = *(const float2*)((const char*)p.x + idx);
          float2 o;
          o.x = xv.x + (odd ? recv : va); o.y = xv.y + (odd ? vb : recv);
          *(float2*)((char*)p.out + idx) = o;
        }
  }
}

__device__ __forceinline__ void dt_piece(const Params& p, char* smem, int m0) {
  const int tid = threadIdx.x, lane = tid & 63, w = tid >> 6, r32 = lane & 31, hh = lane >> 5;
  const u16* U = (const u16*)((const char*)p.out + OOFF_U);
  const u16* Wd = (const u16*)((const char*)p.out + OOFF_WINT) + (size_t)6656 * 1024;
  float* red = (float*)smem;
  f32x16 acc[2];
#pragma unroll
  for (int i = 0; i < 2; i++)
#pragma unroll
    for (int r = 0; r < 16; r++) acc[i][r] = 0.f;
  bf16x8 af[2][8], bfr[8];
  const int kb = w * 128 + hh * 8;
#pragma unroll
  for (int ks = 0; ks < 8; ks++) {
    bfr[ks] = *(const bf16x8*)(Wd + (size_t)r32 * 1024 + kb + ks * 16);
#pragma unroll
    for (int i = 0; i < 2; i++) af[i][ks] = *(const bf16x8*)(U + (size_t)(m0 + i * 32 + r32) * 1024 + kb + ks * 16);
  }
#pragma unroll
  for (int ks = 0; ks < 8; ks++)
#pragma unroll
    for (int i = 0; i < 2; i++) acc[i] = MFMA32(af[i][ks], bfr[ks], acc[i]);
  __syncthreads();
#pragma unroll
  for (int i = 0; i < 2; i++)
#pragma unroll
    for (int reg = 0; reg < 16; reg++)
      red[(w * 64 + i * 32 + (reg & 3) + 8 * (reg >> 2) + 4 * hh) * 32 + r32] = acc[i][reg];
  __syncthreads();
  float* DT = (float*)(p.ws + OFF_DT);
#pragma unroll
  for (int o = tid; o < 1024; o += 512) {
    const int row = o >> 4, col = o & 15;
    float v = p.dt_bias[col];
#pragma unroll
    for (int ww = 0; ww < 8; ww++) v += red[(ww * 64 + row) * 32 + col];
    DT[(m0 + row) * 16 + col] = fmaxf(v, 0.f) + log1pf(__expf(-fabsf(v)));
  }
  __syncthreads();
}

template <int MODE>
__device__ __forceinline__ void gemm_phase(const Params& p, char* smem, bool dry, int vbid) {
  (void)dry;
  const int bid = vbid;
  if (gridDim.x == 256) {
    const int x = bid & 7, j = bid >> 3;
    const int m0 = (x * 8 + (j & 7)) * 256, nq = j >> 3;
    if (MODE == 0) {
#pragma unroll 1
      for (int r = 0; r < 6; r++) {
        const int n0 = (r * 4 + nq) * 256;
        gemm_tile<0, 4, false>(p, smem, m0, n0);
      }
      gemm_tile<0, 2, false>(p, smem, m0, 6144 + nq * 128);
      dt_piece(p, smem, (int)blockIdx.x * 64);
    } else {
      gemm_tile<1, 4, true>(p, smem, m0, nq * 256);
    }
  } else {
    constexpr int NTN = MODE == 0 ? 53 : 8;
    for (int tile = bid; tile < 64 * NTN; tile += gridDim.x) {
      const int n0 = (tile >> 6) * 128;
      gemm_tile<MODE, 2, MODE == 1>(p, smem, (tile & 63) * 256, n0);
    }
  }
}

template <typename F>
__device__ __forceinline__ void conv_run32(const u16* xbc0, int col, bool first_chunk, int l0, const float* cw, const float* cb, F f) {
  const float w0 = cw[col], w1 = cw[1536 + col], w2 = cw[2 * 1536 + col], w3 = cw[3 * 1536 + col], bias = cb[col];
  float u[35];
#pragma unroll
  for (int i = 0; i < 35; i++) {
    const int l = l0 - 3 + i;
    u[i] = (first_chunk && l < 0) ? 0.f : bf2f((uint32_t)xbc0[(ptrdiff_t)l * 1536 + col]);
  }
#pragma unroll
  for (int i = 0; i < 32; i++) {
    const float v = w0 * u[i] + w1 * u[i + 1] + w2 * u[i + 2] + w3 * u[i + 3] + bias;
    f(i, silu(v));
  }
}

__device__ __forceinline__ void phase_states(const Params& p, char* smem) {
  u16* BT = (u16*)smem;
  u16* XT = BT + 128 * 136;
  float* wl = (float*)(XT + 2 * 64 * 136);
  const int tid = threadIdx.x, lane = tid & 63, w = tid >> 6, r32 = lane & 31, hh = lane >> 5;
  const int hg = w >> 2, wq = w & 3;
  const u16* XBC = (const u16*)(p.ws + OFF_XBC);
  const float* DT = (const float*)(p.ws + OFF_DT);
  float* CD = (float*)(p.ws + OFF_CD);
  u16* ST = (u16*)p.out;
  for (int item = blockIdx.x; item < 256; item += gridDim.x) {
    const int g = item & 1, bc = item >> 1, c = bc & 63, b = bc >> 6;
    const int tok0 = b * 8192 + c * 128;
    const u16* xbc0 = XBC + (size_t)tok0 * 1536;
    {
      const int h = g * 8 + w;
      const float v0 = DT[(tok0 + 2 * lane) * 16 + h], v1 = DT[(tok0 + 2 * lane + 1) * 16 + h];
      float sc = v0 + v1;
#pragma unroll
      for (int d = 1; d < 64; d <<= 1) { float t = __shfl_up(sc, d); if (lane >= d) sc += t; }
      const float A = -__expf(p.a_log[h]);
      const float tot = __shfl(sc, 63);
      const float e = sc - (v0 + v1);
      wl[w * 128 + 2 * lane] = v0 * __expf(A * (tot - (e + v0)));
      wl[w * 128 + 2 * lane + 1] = v1 * __expf(A * (tot - sc));
      if (lane == 0) CD[bc * 16 + h] = __expf(A * tot);
    }
    {
      const int ch = tid & 127, q = tid >> 7;
      u16* dst = BT + ch * 136 + q * 32;
      uint32_t pk[16];
      conv_run32(xbc0, 1024 + g * 128 + ch, c == 0, q * 32, p.conv_w, p.conv_b, [&](int i, float v) {
        const uint32_t hb = f2bf(v);
        if (i & 1) pk[i >> 1] |= hb << 16; else pk[i >> 1] = hb;
      });
#pragma unroll
      for (int j = 0; j < 4; j++) { u32x4 o; o.x = pk[4 * j]; o.y = pk[4 * j + 1]; o.z = pk[4 * j + 2]; o.w = pk[4 * j + 3]; *(u32x4*)(dst + 8 * j) = o; }
    }
    for (int hi = 0; hi < 4; hi++) {
      const int hl = hg * 4 + hi, h = g * 8 + hl;
      __syncthreads();
      {
        const int t = tid & 255, ch = t & 63, q = t >> 6;
        u16* dst = XT + hg * 64 * 136 + ch * 136 + q * 32;
        const float* wlh = wl + hl * 128 + q * 32;
        uint32_t pk[16], pg[16];
        float pv = 0.f, ps = 0.f;
        conv_run32(xbc0, h * 64 + ch, c == 0, q * 32, p.conv_w, p.conv_b, [&](int i, float v) {
          const float sc = v * wlh[i];
          if (i & 1) { pk[i >> 1] = pack2(ps, sc); pg[i >> 1] = pack2(pv, v); } else { pv = v; ps = sc; }
        });
        u16* dstg = (u16*)((char*)p.out + OOFF_XTG) + ((size_t)(bc * 16 + h) * 64 + ch) * 128 + q * 32;
#pragma unroll
        for (int j = 0; j < 4; j++) {
          u32x4 o; o.x = pk[4 * j]; o.y = pk[4 * j + 1]; o.z = pk[4 * j + 2]; o.w = pk[4 * j + 3]; *(u32x4*)(dst + 8 * j) = o;
          u32x4 og; og.x = pg[4 * j]; og.y = pg[4 * j + 1]; og.z = pg[4 * j + 2]; og.w = pg[4 * j + 3]; *(u32x4*)(dstg + 8 * j) = og;
        }
      }
      __syncthreads();
      {
        const u16* xt = XT + hg * 64 * 136;
        f32x16 acc[2];
#pragma unroll
        for (int mt = 0; mt < 2; mt++)
#pragma unroll
          for (int r = 0; r < 16; r++) acc[mt][r] = 0.f;
#pragma unroll
        for (int ks = 0; ks < 8; ks++) {
          const bf16x8 bb = *(const bf16x8*)(BT + (wq * 32 + r32) * 136 + ks * 16 + hh * 8);
#pragma unroll
          for (int mt = 0; mt < 2; mt++) {
            const bf16x8 a = *(const bf16x8*)(xt + (mt * 32 + r32) * 136 + ks * 16 + hh * 8);
            acc[mt] = MFMA32(a, bb, acc[mt]);
          }
        }
        u16* dst = ST + ((size_t)(bc * 16 + h) * 64) * 128;
#pragma unroll
        for (int mt = 0; mt < 2; mt++)
#pragma unroll
          for (int reg = 0; reg < 16; reg++) {
            const int pp = mt * 32 + (reg & 3) + 8 * (reg >> 2) + 4 * hh;
            dst[pp * 128 + wq * 32 + r32] = f2bf(acc[mt][reg]);
          }
      }
    }
    __syncthreads();
  }
}

__device__ __forceinline__ void phase_scan(const Params& p) {
  const u16* ST = (const u16*)p.out;
  const float* CD = (const float*)(p.ws + OFF_CD);
  u16* PREV = (u16*)(p.ws + OFF_PREV);
  for (int idx = blockIdx.x * 512 + threadIdx.x; idx < 131072; idx += gridDim.x * 512) {
    const int e = idx * 2;
    const int b = e >> 17, rem = e & 131071, h = rem >> 13;
    float hx = 0.f, hy = 0.f;
#pragma unroll 32
    for (int c = 0; c < 64; c++) {
      const size_t off = (size_t)(b * 64 + c) * 131072 + rem;
      const uint32_t sw = *(const uint32_t*)(ST + off);
      float2 s; s.x = bflo(sw); s.y = bfhi(sw);
      const float d = CD[(b * 64 + c) * 16 + h];
      *(uint32_t*)(PREV + off) = pack2(hx, hy);
      hx = hx * d + s.x; hy = hy * d + s.y;
    }
  }
}

__device__ __forceinline__ void ssd_out_item(const Params& p, char* smem, int item, bool dry) {
  const int g = item & 1, bc = item >> 1, c = bc & 63, b = bc >> 6;
  const int tok0 = b * 8192 + c * 128;
  u16* R1 = (u16*)smem;
  u16* R2 = R1 + 128 * 136;
  u16* XT = R2 + 128 * 136;
  float* dts = (float*)(XT + 2 * 64 * 136);
  float* acs = dts + 1024;
  float* part = acs + 1024;
  float* rstd = part + 256;
  u16* PVB = (u16*)(rstd + 128);
  const int tid = threadIdx.x, lane = tid & 63, w = tid >> 6, r32 = lane & 31, hh = lane >> 5;
  const int lt = w & 3, hg = w >> 2;
  const u16* xbc0 = (const u16*)(p.ws + OFF_XBC) + (size_t)tok0 * 1536;
  const float* DT = (const float*)(p.ws + OFF_DT);
  u16* ZS = (u16*)(p.ws + OFF_ZS);
  const u16* PREV = (const u16*)(p.ws + OFF_PREV);
  const bool first = (c == 0);
  {
    const int h = g * 8 + w;
    const float v0 = DT[(tok0 + 2 * lane) * 16 + h], v1 = DT[(tok0 + 2 * lane + 1) * 16 + h];
    float sc = v0 + v1;
#pragma unroll
    for (int d = 1; d < 64; d <<= 1) { float t = __shfl_up(sc, d); if (lane >= d) sc += t; }
    const float A = -__expf(p.a_log[h]);
    const float e = sc - (v0 + v1);
    dts[w * 128 + 2 * lane] = v0; dts[w * 128 + 2 * lane + 1] = v1;
    acs[w * 128 + 2 * lane] = A * (e + v0); acs[w * 128 + 2 * lane + 1] = A * sc;
  }
  {
    const int ch = tid & 127, q = tid >> 7;
    conv_run32(xbc0, 1280 + g * 128 + ch, first, q * 32, p.conv_w, p.conv_b, [&](int i, float v) { R1[(q * 32 + i) * 136 + ch] = f2bf(v); });
    conv_run32(xbc0, 1024 + g * 128 + ch, first, q * 32, p.conv_w, p.conv_b, [&](int i, float v) { R2[(q * 32 + i) * 136 + ch] = f2bf(v); });
  }
  __syncthreads();
  const u16* cfp = R1 + (lt * 32 + r32) * 136 + hh * 8;
  float ss[16];
#pragma unroll
  for (int r = 0; r < 16; r++) ss[r] = 0.f;
  u32x4 xr[4];
  {
    const char* src = (const char*)p.out + OOFF_XTG + (size_t)(bc * 16 + g * 8 + hg * 4) * 16384;
#pragma unroll
    for (int i = 0; i < 4; i++) xr[i] = *(const u32x4*)(src + ((tid & 255) + 256 * i) * 16);
  }
  for (int hi = 0; hi < 4; hi++) {
    const int h = g * 8 + hg * 4 + hi;
    __syncthreads();
    {
      const int t = tid & 255;
      u16* dstb = XT + hg * 64 * 136;
#pragma unroll
      for (int i = 0; i < 4; i++) {
        const int id = t + 256 * i, row = id >> 4, cc = id & 15;
        *(u32x4*)(dstb + row * 136 + cc * 8) = xr[i];
        *(u32x4*)(PVB + hg * 64 * 136 + row * 136 + cc * 8) = *(const u32x4*)((const char*)PREV + (size_t)(bc * 16 + h) * 16384 + id * 16);
      }
    }
    __syncthreads();
    if (hi < 3) {
      const char* src = (const char*)p.out + OOFF_XTG + (size_t)(bc * 16 + h + 1) * 16384;
#pragma unroll
      for (int i = 0; i < 4; i++) xr[i] = *(const u32x4*)(src + ((tid & 255) + 256 * i) * 16);
    }
    const float* acs_h = acs + (hg * 4 + hi) * 128;
    const float* dts_h = dts + (hg * 4 + hi) * 128;
    const u16* xt = XT + hg * 64 * 136;
    f32x16 acc[2];
#pragma unroll
    for (int pt = 0; pt < 2; pt++)
#pragma unroll
      for (int r = 0; r < 16; r++) acc[pt][r] = 0.f;
    const uint32_t zoff0 = ((uint32_t)(tok0 + lt * 32 + 4 * hh) * 1024u + (uint32_t)(h * 64 + r32)) * 2u;
    u16 zraw[2][16];
#pragma unroll
    for (int reg = 0; reg < 16; reg++)
      zraw[0][reg] = *(const u16*)((const char*)ZS + (zoff0 + (uint32_t)(((reg & 3) + 8 * (reg >> 2)) * 2048)));
    const u16* prev_h = PVB + hg * 64 * 136;
#pragma unroll
    for (int ks = 0; ks < 8; ks++)
#pragma unroll
      for (int pt = 0; pt < 2; pt++) {
        bf16x8 bfr = *(const bf16x8*)(prev_h + (pt * 32 + r32) * 136 + ks * 16 + hh * 8);
        acc[pt] = MFMA32(*(const bf16x8*)(cfp + ks * 16), bfr, acc[pt]);
      }
#pragma unroll
    for (int reg = 0; reg < 16; reg++) {
      const float e = __expf(acs_h[lt * 32 + (reg & 3) + 8 * (reg >> 2) + 4 * hh]);
      acc[0][reg] *= e; acc[1][reg] *= e;
    }
    const int lcol = lt * 32 + r32;
    const float acs_l = acs_h[lcol];
#pragma unroll 1
    for (int st = 0; st <= lt; st++) {
      {
        f32x16 Xs;
#pragma unroll
        for (int r = 0; r < 16; r++) Xs[r] = 0.f;
#pragma unroll
        for (int ks = 0; ks < 8; ks++) {
          bf16x8 a = *(const bf16x8*)(R2 + (st * 32 + r32) * 136 + ks * 16 + hh * 8);
          Xs = MFMA32(a, *(const bf16x8*)(cfp + ks * 16), Xs);
        }
#pragma unroll
        for (int sp = 0; sp < 2; sp++) {
          float gv[8];
#pragma unroll
          for (int j = 0; j < 8; j++) {
            const int reg = 8 * sp + j;
            const int s = st * 32 + (reg & 3) + 8 * (reg >> 2) + 4 * hh;
            const float v = Xs[reg] * __expf(acs_l - acs_h[s]) * dts_h[s];
            gv[j] = (s <= lcol) ? v : 0.f;
          }
          u32x4 aw; aw.x = pack2(gv[0], gv[1]); aw.y = pack2(gv[2], gv[3]); aw.z = pack2(gv[4], gv[5]); aw.w = pack2(gv[6], gv[7]);
          const bf16x8 af = __builtin_bit_cast(bf16x8, aw);
#pragma unroll
          for (int pt = 0; pt < 2; pt++) {
            const u16* xp = xt + (pt * 32 + r32) * 136 + st * 32 + sp * 16 + hh * 4;
            const u32x2 lo = *(const u32x2*)xp, hi2 = *(const u32x2*)(xp + 8);
            u32x4 bw; bw.x = lo.x; bw.y = lo.y; bw.z = hi2.x; bw.w = hi2.y;
            acc[pt] = MFMA32(af, __builtin_bit_cast(bf16x8, bw), acc[pt]);
          }
        }
      }
    }
    const float dsk = p.d_skip[h];
#pragma unroll
    for (int reg = 0; reg < 16; reg++)
      zraw[1][reg] = *(const u16*)((const char*)ZS + (zoff0 + (uint32_t)(((reg & 3) + 8 * (reg >> 2)) * 2048 + 64)));
#pragma unroll
    for (int pt = 0; pt < 2; pt++)
#pragma unroll
      for (int rg = 0; rg < 4; rg++) {
        const u32x2 xv = *(const u32x2*)(xt + (pt * 32 + r32) * 136 + lt * 32 + 8 * rg + 4 * hh);
#pragma unroll
        for (int i = 0; i < 4; i++) {
          const int reg = rg * 4 + i;
          const int l = lt * 32 + 8 * rg + 4 * hh + i;
          const uint32_t xw = (i < 2) ? xv.x : xv.y;
          const float xval = (i & 1) ? bfhi(xw) : bflo(xw);
          const float y = acc[pt][reg] + dsk * xval;
          const float z = bf2f((uint32_t)zraw[pt][reg]);
          const float t = y * silu(z);
          ss[reg] += t * t;
          if (!dry) *(u16*)((char*)ZS + (zoff0 + (uint32_t)(((reg & 3) + 8 * (reg >> 2)) * 2048 + pt * 64))) = f2bf(t);
        }
      }
  }
#pragma unroll
  for (int reg = 0; reg < 16; reg++) {
    float v = ss[reg];
#pragma unroll
    for (int o = 1; o < 32; o <<= 1) v += __shfl_xor(v, o);
    if (r32 == 0) part[hg * 128 + lt * 32 + (reg & 3) + 8 * (reg >> 2) + 4 * hh] = v;
  }
  __syncthreads();
  if (tid < 128 && !dry) ((float*)(p.ws + OFF_RSTD))[(tok0 + tid) * 2 + g] = rsqrtf((part[tid] + part[128 + tid]) * (1.f / 512.f) + EPS);
  __syncthreads();
}

__device__ __forceinline__ void attn_item(const Params& p, char* smem, int item, float lam, bool dry, int* qctr, int* s_next) {
  const int h = 7 - (item >> 7), qb = 63 - ((item & 127) >> 1), b = item & 1, bh = b * 8 + h;
  constexpr int KVSTAGE = 64 * 136 + 128 * 72;
  u16* KV = (u16*)smem;
  float* ex = (float*)(KV + 2 * KVSTAGE);
  const int tid = threadIdx.x, lane = tid & 63, w = tid >> 6, r32 = lane & 31, hh = lane >> 5;
  const int qt = w & 3, m = w >> 2;
  const int qpos0 = qb * 128 + qt * 32, qpos = qpos0 + r32;
  const float slope2 = __builtin_amdgcn_exp2f(-(float)(h + 1)) * LOG2E;
  const u16* Qb = (const u16*)(p.ws + OFF_Q);
  const u16* Kb = (const u16*)(p.ws + OFF_K) + (size_t)(b * 8192) * 1024 + h * 128;
  const u16* Vb = (const u16*)(p.ws + OFF_VT) + (size_t)(bh * 128) * 8192;
  u32x4 rk[2], rv[2];
  auto gload = [&](int kt) {
    const int J0 = kt * 64;
#pragma unroll
    for (int i = 0; i < 2; i++) {
      const int id = tid + 512 * i;
      rk[i] = *(const u32x4*)(Kb + (size_t)(J0 + (id >> 4)) * 1024 + (id & 15) * 8);
      rv[i] = *(const u32x4*)(Vb + (size_t)(id >> 3) * 8192 + J0 + (id & 7) * 8);
    }
  };
  auto lstore = [&](int stage) {
    u16* Ks = KV + stage * KVSTAGE;
    u16* Vs = Ks + 64 * 136;
#pragma unroll
    for (int i = 0; i < 2; i++) {
      const int id = tid + 512 * i;
      *(u32x4*)(Ks + (id >> 4) * 136 + (id & 15) * 8) = rk[i];
      u32x2 v0, v1; v0.x = rv[i].x; v0.y = rv[i].y; v1.x = rv[i].z; v1.y = rv[i].w;
      u16* vd = Vs + (id >> 3) * 72 + ((id & 7) >> 1) * 16 + ((id & 1) ? 4 : 0);
      *(u32x2*)(vd) = v0;
      *(u32x2*)(vd + 8) = v1;
    }
  };
  const int nkt = 2 * qb + 2;
  gload(nkt - 1);
  bf16x8 qf[4];
  {
    const u16* qptr = Qb + (size_t)(b * 8192 + qpos) * 1024 + h * 128 + m * 64 + hh * 8;
#pragma unroll
    for (int ks = 0; ks < 4; ks++) qf[ks] = *(const bf16x8*)(qptr + ks * 16);
  }
  float bound2;
  {
    float qn2 = 0.f;
#pragma unroll
    for (int ks = 0; ks < 4; ks++) {
      const u32x4 qw = __builtin_bit_cast(u32x4, qf[ks]);
      qn2 += bflo(qw.x) * bflo(qw.x) + bfhi(qw.x) * bfhi(qw.x) + bflo(qw.y) * bflo(qw.y) + bfhi(qw.y) * bfhi(qw.y);
      qn2 += bflo(qw.z) * bflo(qw.z) + bfhi(qw.z) * bfhi(qw.z) + bflo(qw.w) * bflo(qw.w) + bfhi(qw.w) * bfhi(qw.w);
    }
    qn2 += __shfl_xor(qn2, 32);
    const float kmax2 = __uint_as_float(((const unsigned int*)(p.ws + OFF_KMAX))[bh * 2 + m]);
    bound2 = sqrtf(qn2 * kmax2) * 1.02f;
  }
  bool wdone = false, first = true, fast = false;
  f32x16 O[4];
#pragma unroll
  for (int d = 0; d < 4; d++)
#pragma unroll
    for (int r = 0; r < 16; r++) O[d][r] = 0.f;
  float mrow = -INFINITY, lsum = 0.f;
  lstore((nkt - 1) & 1);
  __syncthreads();
  if (__builtin_amdgcn_readfirstlane(threadIdx.x) >= 256) __builtin_amdgcn_s_setprio(1);
  for (int kt = nkt - 1; kt >= 0; kt--) {
    const int J0 = kt * 64;
    const u16* Ks = KV + (kt & 1) * KVSTAGE;
    const u16* Vs = Ks + 64 * 136;
    if (kt > 0) gload(kt - 1);
    if (fast && !wdone && J0 + 64 <= qpos0) {
      const float base1 = slope2 * (float)(J0 + 32 + 4 * hh - qpos) - mrow;
      const float base0 = base1 - 32.f * slope2;
      f32x16 S1, S0;
#pragma unroll
      for (int reg = 0; reg < 16; reg++) {
        const float c = (float)((reg & 3) + 8 * (reg >> 2));
        S1[reg] = fmaf(slope2, c, base1);
        S0[reg] = fmaf(slope2, c, base0);
      }
#pragma unroll
      for (int ks = 0; ks < 4; ks++) {
        const bf16x8 k1 = *(const bf16x8*)(Ks + (32 + r32) * 136 + m * 64 + ks * 16 + hh * 8);
        const bf16x8 k0 = *(const bf16x8*)(Ks + r32 * 136 + m * 64 + ks * 16 + hh * 8);
        S1 = MFMA32(k1, qf[ks], S1);
        S0 = MFMA32(k0, qf[ks], S0);
      }
      float ps = 0.f;
#pragma unroll
      for (int sub = 1; sub >= 0; sub--) {
        uint32_t pw[8];
#pragma unroll
        for (int j = 0; j < 8; j++) {
          const float p0 = __builtin_amdgcn_exp2f(sub ? S1[2 * j] : S0[2 * j]);
          const float p1 = __builtin_amdgcn_exp2f(sub ? S1[2 * j + 1] : S0[2 * j + 1]);
          ps += p0 + p1;
          pw[j] = pack2(p0, p1);
        }
        u32x4 t0, t1; t0.x = pw[0]; t0.y = pw[1]; t0.z = pw[2]; t0.w = pw[3]; t1.x = pw[4]; t1.y = pw[5]; t1.z = pw[6]; t1.w = pw[7];
        const bf16x8 pf0 = __builtin_bit_cast(bf16x8, t0), pf1 = __builtin_bit_cast(bf16x8, t1);
#pragma unroll
        for (int d = 0; d < 4; d++)
#pragma unroll
          for (int sp = 0; sp < 2; sp++) {
            const bf16x8 vfr = *(const bf16x8*)(Vs + (d * 32 + r32) * 72 + sub * 32 + sp * 16 + hh * 8);
            O[d] = MFMA32(vfr, sp ? pf1 : pf0, O[d]);
          }
      }
      lsum += ps;
    } else
#pragma unroll
    for (int sub = 1; sub >= 0; sub--) {
      const int Js = J0 + sub * 32;
      if (!wdone && Js <= qpos0 + 31) {
        const float ref = first ? 0.f : mrow;
        const float base = slope2 * (float)(Js + 4 * hh - qpos) - ref;
        f32x16 S;
#pragma unroll
        for (int reg = 0; reg < 16; reg++) S[reg] = fmaf(slope2, (float)((reg & 3) + 8 * (reg >> 2)), base);
        bf16x8 kf[4];
#pragma unroll
        for (int ks = 0; ks < 4; ks++) kf[ks] = *(const bf16x8*)(Ks + (sub * 32 + r32) * 136 + m * 64 + ks * 16 + hh * 8);
        bf16x8 vf[4][2];
#pragma unroll
        for (int d = 0; d < 4; d++)
#pragma unroll
          for (int sp = 0; sp < 2; sp++) {
            vf[d][sp] = *(const bf16x8*)(Vs + (d * 32 + r32) * 72 + sub * 32 + sp * 16 + hh * 8);
          }
#pragma unroll
        for (int ks = 0; ks < 4; ks++) S = MFMA32(kf[ks], qf[ks], S);
        if (!fast) {
          const bool diag = (Js + 31 > qpos0);
          float mx = -INFINITY;
#pragma unroll
          for (int reg = 0; reg < 16; reg++) {
            const int key = Js + (reg & 3) + 8 * (reg >> 2) + 4 * hh;
            if (diag && key > qpos) S[reg] = -INFINITY;
            mx = fmaxf(mx, S[reg]);
          }
          mx = fmaxf(mx, __shfl_xor(mx, 32));
          const float mrel = first ? mx : fmaxf(mx, 0.f);
          const float alpha = first ? 0.f : __builtin_amdgcn_exp2f(-mrel);
          if (__any(alpha != 1.f)) {
#pragma unroll
            for (int d = 0; d < 4; d++)
#pragma unroll
              for (int r = 0; r < 16; r++) O[d][r] *= alpha;
            lsum *= alpha;
          }
          mrow = ref + mrel;
#pragma unroll
          for (int reg = 0; reg < 16; reg++) S[reg] -= mrel;
          first = false;
          fast = __all(bound2 - mrow <= 100.f);
        }
        float ps = 0.f;
        uint32_t pw[8];
#pragma unroll
        for (int j = 0; j < 8; j++) {
          const float p0 = __builtin_amdgcn_exp2f(S[2 * j]), p1 = __builtin_amdgcn_exp2f(S[2 * j + 1]);
          ps += p0 + p1;
          pw[j] = pack2(p0, p1);
        }
        lsum += ps;
        u32x4 t0, t1; t0.x = pw[0]; t0.y = pw[1]; t0.z = pw[2]; t0.w = pw[3]; t1.x = pw[4]; t1.y = pw[5]; t1.z = pw[6]; t1.w = pw[7];
        const bf16x8 pf0 = __builtin_bit_cast(bf16x8, t0), pf1 = __builtin_bit_cast(bf16x8, t1);
#pragma unroll
        for (int d = 0; d < 4; d++) {
#pragma unroll
          for (int sp = 0; sp < 2; sp++) O[d] = MFMA32(vf[d][sp], sp ? pf1 : pf0, O[d]);
        }
      }
    }
    if (!wdone) wdone = __all((bound2 - slope2 * (float)(qpos - (J0 - 1)) - mrow) < -40.f);
    if (kt > 0) lstore((kt - 1) & 1);
    if (!__syncthreads_or(!wdone)) break;
  }
  __builtin_amdgcn_s_setprio(0);
  int nxt = 0;
  if (tid == 256 && qctr) nxt = atomicAdd(qctr, 1);
  u32x2 zpre[4][4];
  {
    const uint32_t zoff = ((uint32_t)(b * 8192 + qpos) * 1024u + (uint32_t)(h * 128 + 4 * hh)) * 2u;
#pragma unroll
    for (int d = 0; d < 4; d++)
#pragma unroll
      for (int rg = 0; rg < 4; rg++)
        zpre[d][rg] = (m == 0) ? *(const u32x2*)((const char*)p.ws + OFF_ZA + (zoff + (uint32_t)((d * 32 + 8 * rg) * 2))) : u32x2{0u, 0u};
  }
  lsum += __shfl_xor(lsum, 32);
  const float inv = 1.f / lsum;
  if (m == 1) {
    const float sc = inv * lam;
#pragma unroll
    for (int d = 0; d < 4; d++)
#pragma unroll
      for (int reg = 0; reg < 16; reg++)
        ex[(qt * 128 + d * 32 + (reg & 3) + 8 * (reg >> 2) + 4 * hh) * 32 + r32] = O[d][reg] * sc;
  }
  __syncthreads();
  if (m == 0 && !dry) {
    float ssq = 0.f;
#pragma unroll
    for (int d = 0; d < 4; d++)
#pragma unroll
      for (int reg = 0; reg < 16; reg++) {
        const float v = O[d][reg] * inv - ex[(qt * 128 + d * 32 + (reg & 3) + 8 * (reg >> 2) + 4 * hh) * 32 + r32];
        O[d][reg] = v; ssq += v * v;
      }
    ssq += __shfl_xor(ssq, 32);
    const float rs = rsqrtf(ssq * (1.f / 128.f) + EPS) * 0.8f;
    const size_t rowoff = (size_t)(b * 8192 + qpos) * 1024 + h * 128;
    u16* YA = (u16*)(p.ws + OFF_Q);
#pragma unroll
    for (int d = 0; d < 4; d++)
#pragma unroll
      for (int rg = 0; rg < 4; rg++) {
        const int dv0 = d * 32 + 8 * rg + 4 * hh;
        const u32x2 zv = zpre[d][rg];
        const float4 sg = *(const float4*)(p.subln_gain + dv0);
        u32x2 o;
        o.x = pack2(O[d][rg * 4 + 0] * rs * sg.x * silu(bflo(zv.x)), O[d][rg * 4 + 1] * rs * sg.y * silu(bfhi(zv.x)));
        o.y = pack2(O[d][rg * 4 + 2] * rs * sg.z * silu(bflo(zv.y)), O[d][rg * 4 + 3] * rs * sg.w * silu(bfhi(zv.y)));
        *(u32x2*)(YA + rowoff + dv0) = o;
      }
  }
  if (tid == 256 && qctr) *s_next = nxt;
  __syncthreads();
}

__device__ __forceinline__ void phase_final(const Params& p) {
  const int tid = threadIdx.x, lane = tid & 63, wid = tid >> 6;
  for (int row0 = (blockIdx.x * 8 + wid) * 8; row0 < T_; row0 += gridDim.x * 64) {
    float4 v[8][4]; float ss[8];
#pragma unroll
    for (int r = 0; r < 8; r++) {
      const float4* orow = (const float4*)(p.out + (size_t)(row0 + r) * 1024);
#pragma unroll
      for (int i = 0; i < 4; i++) v[r][i] = orow[lane + 64 * i];
    }
#pragma unroll
    for (int r = 0; r < 8; r++) {
      float t = 0.f;
#pragma unroll
      for (int i = 0; i < 4; i++) t += v[r][i].x * v[r][i].x + v[r][i].y * v[r][i].y + v[r][i].z * v[r][i].z + v[r][i].w * v[r][i].w;
      ss[r] = rsqrtf(wave_sum(t) * (1.f / 1024.f) + EPS);
    }
#pragma unroll
    for (int i = 0; i < 4; i++) {
      const float4 g = ((const float4*)p.final_gain)[lane + 64 * i];
#pragma unroll
      for (int r = 0; r < 8; r++) {
        const float rs = ss[r];
        float4 o; o.x = v[r][i].x * rs * g.x; o.y = v[r][i].y * rs * g.y; o.z = v[r][i].z * rs * g.z; o.w = v[r][i].w * rs * g.w;
        ((float4*)(p.out + (size_t)(row0 + r) * 1024))[lane + 64 * i] = o;
      }
    }
  }
}

#ifndef PROBE
#define PROBE 0
#endif
__global__ void __launch_bounds__(512) fwd_megakernel(Params p) {
  cg::grid_group grid = cg::this_grid();
  extern __shared__ __attribute__((aligned(16))) char smem[];
  __shared__ int s_item;
  __shared__ uint4 xb_words;
  if (threadIdx.x == 0) xb_words = make_uint4(0u, 0u, 0u, 0u);
  __syncthreads();
  const XcdBarrier xb = xcd_barrier_post((unsigned*)(p.ws + OFF_BAR), (volatile LAS unsigned*)&xb_words);
#define GSYNC() xcd_barrier(xb)
  if (p.out == nullptr) grid.sync();
  phase_prep(p, smem);
  GSYNC();
  if (threadIdx.x == 0) {
    unsigned* bar = (unsigned*)(p.ws + OFF_BAR);
    unsigned pre = 0u;
    for (unsigned jx = 0; jx < xb.x; ++jx) pre += xb_ld(&bar[XB_XCNT(jx)]);
    const unsigned v = pre + xb_words.z;
    xb_words.w = (gridDim.x == 256) ? ((v & 31u) * 8u + (v >> 5)) : v;
  }
  __syncthreads();
#if PROBE == 2
  phase_prep(p, smem);
  GSYNC();
  if (threadIdx.x == 0) {
    unsigned* bar = (unsigned*)(p.ws + OFF_BAR);
    unsigned pre = 0u;
    for (unsigned jx = 0; jx < xb.x; ++jx) pre += xb_ld(&bar[XB_XCNT(jx)]);
    const unsigned v = pre + xb_words.z;
    xb_words.w = (gridDim.x == 256) ? ((v & 31u) * 8u + (v >> 5)) : v;
  }
  __syncthreads();
#endif
  gemm_phase<0>(p, smem, false, (int)xb_words.w);
  GSYNC();
#if PROBE == 1
  gemm_phase<0>(p, smem, false, (int)xb_words.w);
  GSYNC();
#endif
  phase_states(p, smem);
  GSYNC();
  phase_scan(p);
  GSYNC();
#if PROBE == 3
  phase_states(p, smem);
  GSYNC();
  phase_scan(p);
  GSYNC();
#endif
#if PROBE == 7
  for (int it = blockIdx.x; it < 256; it += gridDim.x) ssd_out_item(p, smem, it, true);
#endif
#if PROBE == 6
  GSYNC(); GSYNC(); GSYNC(); GSYNC(); GSYNC(); GSYNC();
#endif
  for (int it = blockIdx.x; it < 256; it += gridDim.x) ssd_out_item(p, smem, it, false);
  {
    const int lane = threadIdx.x & 63;
    const float s1 = wave_sum(p.lq1[lane] * p.lk1[lane]);
    const float s2 = wave_sum(p.lq2[lane] * p.lk2[lane]);
    const float lam = __expf(s1) - __expf(s2) + 0.2f;
    int* ctr = (int*)(p.ws + OFF_CTR);
#if PROBE == 4
    while (true) {
      if (threadIdx.x == 0) s_item = atomicAdd(ctr + 1, 1);
      __syncthreads();
      const int item = s_item;
      __syncthreads();
      if (item >= 1024) break;
      attn_item(p, smem, item, lam, true, nullptr, nullptr);
    }
#endif
    if (threadIdx.x == 0) s_item = atomicAdd(ctr, 1);
    __syncthreads();
    int item = s_item;
    __syncthreads();
    while (item < 1024) {
      attn_item(p, smem, item, lam, false, ctr, &s_item);
      item = s_item;
    }
  }
  GSYNC();
#if PROBE == 5
  gemm_phase<1>(p, smem, true, (int)xb_words.w);
  GSYNC();
#endif
  gemm_phase<1>(p, smem, false, (int)xb_words.w);
  GSYNC();
  phase_final(p);
}

extern "C" void kernel_launch(void* const* d_in, const int* in_sizes, int n_in, void* d_out, int out_size,
                              void* d_ws, size_t ws_size, hipStream_t stream) {
  static int grid_blocks = 0;
  if (grid_blocks == 0) {
    int dev = 0, cus = 0, per_cu = 0;
    hipGetDevice(&dev);
    hipDeviceGetAttribute(&cus, hipDeviceAttributeMultiprocessorCount, dev);
    if (ws_size < WS_NEED || out_size != T_ * 1024) { fprintf(stderr, "workspace too small: %zu < %zu\n", ws_size, (size_t)WS_NEED); grid_blocks = -1; return; }
    if (hipFuncSetAttribute((const void*)fwd_megakernel, hipFuncAttributeMaxDynamicSharedMemorySize, LDS_BYTES) != hipSuccess) {
      fprintf(stderr, "hipFuncSetAttribute failed\n"); grid_blocks = -1; return;
    }
    hipOccupancyMaxActiveBlocksPerMultiprocessor(&per_cu, (const void*)fwd_megakernel, 512, LDS_BYTES);
    if (per_cu < 1) { fprintf(stderr, "occupancy query says %d blocks/CU\n", per_cu); grid_blocks = -1; return; }
    grid_blocks = cus;
  }
  if (grid_blocks < 0) return;
  Params p{};
  p.x = (const float*)d_in[0]; p.norm_gain = (const float*)d_in[1]; p.w_in = (const float*)d_in[2];
  p.conv_w = (const float*)d_in[3]; p.conv_b = (const float*)d_in[4]; p.dt_bias = (const float*)d_in[5];
  p.a_log = (const float*)d_in[6]; p.d_skip = (const float*)d_in[7]; p.ssd_norm_gain = (const float*)d_in[8];
  p.lq1 = (const float*)d_in[9]; p.lk1 = (const float*)d_in[10]; p.lq2 = (const float*)d_in[11];
  p.lk2 = (const float*)d_in[12]; p.subln_gain = (const float*)d_in[13]; p.w_out = (const float*)d_in[14];
  p.final_gain = (const float*)d_in[15];
  p.out = (float*)d_out; p.ws = (char*)d_ws;
  if (hipMemsetAsync((char*)d_ws + OFF_CTR, 0, 256 + XCD_BAR_WORDS * 4, stream) != hipSuccess) { fprintf(stderr, "memset failed\n"); return; }
  void* args[] = {&p};
  hipError_t e = hipLaunchCooperativeKernel((const void*)fwd_megakernel, dim3(grid_blocks), dim3(512), args, LDS_BYTES, stream);
  if (e != hipSuccess) fprintf(stderr, "cooperative launch failed: %s (grid %d)\n", hipGetErrorString(e), grid_blocks);
}
```

```cpp
#include <hip/hip_runtime.h>
#include <hip/hip_cooperative_groups.h>
#include <cstdio>
#include <cstdint>
#include <cstddef>
#include <type_traits>
namespace cg = cooperative_groups;

typedef unsigned short u16;
typedef short bf16x8 __attribute__((ext_vector_type(8)));
typedef float f32x16 __attribute__((ext_vector_type(16)));
typedef uint32_t u32x4 __attribute__((ext_vector_type(4)));
typedef uint32_t u32x2 __attribute__((ext_vector_type(2)));
#define MFMA32(a, b, c) __builtin_amdgcn_mfma_f32_32x32x16_bf16((a), (b), (c), 0, 0, 0)

struct Params {
  const float* x; const float* norm_gain; const float* w_in; const float* conv_w; const float* conv_b;
  const float* dt_bias; const float* a_log; const float* d_skip; const float* ssd_norm_gain;
  const float* lq1; const float* lk1; const float* lq2; const float* lk2; const float* subln_gain;
  const float* w_out; const float* final_gain;
  float* out; char* ws;
};

constexpr int T_ = 16384;
constexpr float EPS = 1e-5f;
constexpr float LOG2E = 1.4426950408889634f;
constexpr int LDS_BYTES = 150 * 1024;
constexpr int NPAD = 6784;

constexpr size_t OFF_WOUTT = 0;
constexpr size_t OFF_PREV = 4194304;
constexpr size_t OFF_ZS = OFF_PREV + 33554432;
constexpr size_t OFF_XBC = OFF_ZS + 33554432;
constexpr size_t OFF_DT = OFF_XBC + 50331648;
constexpr size_t OFF_Q = OFF_DT + 1048576;
constexpr size_t OFF_K = OFF_Q + 33554432;
constexpr size_t OFF_VT = OFF_K + 33554432;
constexpr size_t OFF_ZA = OFF_VT + 33554432;
constexpr size_t OFF_CD = OFF_ZA + 33554432;
constexpr size_t OFF_ROWSS = OFF_CD + 8192;
constexpr size_t OFF_CTR = OFF_ROWSS + 65536;
constexpr size_t OFF_KMAX = OFF_CTR + 64;
constexpr size_t OFF_BAR = OFF_CTR + 256;
constexpr size_t OFF_RSTD = OFF_BAR + 16384;
constexpr size_t WS_NEED = OFF_RSTD + 131072;
constexpr size_t OOFF_WINT = 0;
constexpr size_t OOFF_U = 16777216;
constexpr size_t OOFF_XTG = 33554432;

typedef __bf16 bf16x2_t __attribute__((ext_vector_type(2)));
typedef float f32x2_t __attribute__((ext_vector_type(2)));
__device__ __forceinline__ uint32_t pack2(float a, float b) {
  f32x2_t v; v.x = a; v.y = b;
  return __builtin_bit_cast(uint32_t, __builtin_convertvector(v, bf16x2_t));
}
__device__ __forceinline__ u16 f2bf(float f) { return (u16)(pack2(f, 0.f) & 0xFFFFu); }
__device__ __forceinline__ float bf2f(uint32_t h) { return __uint_as_float(h << 16); }
__device__ __forceinline__ float bflo(uint32_t w) { return __uint_as_float(w << 16); }
__device__ __forceinline__ float bfhi(uint32_t w) { return __uint_as_float(w & 0xFFFF0000u); }
__device__ __forceinline__ float silu(float v) { return v * __builtin_amdgcn_rcpf(1.f + __expf(-v)); }
__device__ __forceinline__ float wave_sum(float v) {
#pragma unroll
  for (int o = 32; o > 0; o >>= 1) v += __shfl_xor(v, o);
  return v;
}


#define XB_TMO      128
#define XB_XCNT(j)  (256  + 64 * (j))
#define XB_XSUB(j)  (1280 + 64 * (j))
#define XB_XGEN(j)  (2304 + 64 * (j))
#define XB_TOP      3328
#define XB_TOPGEN   3392
#define XCD_BAR_WORDS 3456
#define XB_SPIN_CAP (1u << 18)
#define LAS __attribute__((address_space(3)))
__device__ __forceinline__ unsigned xb_ld(unsigned* p)              { return __hip_atomic_load(p, __ATOMIC_RELAXED, __HIP_MEMORY_SCOPE_AGENT); }
__device__ __forceinline__ unsigned xb_add(unsigned* p, unsigned v) { return __hip_atomic_fetch_add(p, v, __ATOMIC_RELAXED, __HIP_MEMORY_SCOPE_AGENT); }
__device__ __forceinline__ unsigned xb_xcc_id() { return (unsigned)__builtin_amdgcn_s_getreg((3 << 11) | 20) & 0xFu; }
#define XB_SPIN(cond, bar) do { unsigned _sp = 0; while (cond) { __builtin_amdgcn_s_sleep(1); \
    if ((++_sp & 255u) == 0u) { if (xb_ld(&(bar)[XB_TMO])) break; if (_sp > XB_SPIN_CAP) { atomicAdd(&(bar)[XB_TMO], 1u); break; } } } } while (0)
struct XcdBarrier { unsigned* bar; unsigned x; volatile LAS unsigned* st; };
__device__ __forceinline__ XcdBarrier xcd_barrier_post(unsigned* bar, volatile LAS unsigned* st) {
  XcdBarrier b; b.bar = bar; b.x = xb_xcc_id(); b.st = st;
  if (threadIdx.x == 0) st[2] = xb_add(&bar[XB_XCNT(b.x)], 1u);
  return b;
}
__device__ __forceinline__ void xcd_barrier_complete(unsigned* bar, unsigned x, unsigned& nloc, unsigned& nx) {
  const unsigned G = gridDim.x * gridDim.y * gridDim.z;
  unsigned sum, cnt, mine, sp = 0u;
  for (;;) {
    sum = 0u; cnt = 0u; mine = 0u;
#pragma unroll
    for (unsigned j = 0; j < 16; ++j) { const unsigned c = xb_ld(&bar[XB_XCNT(j)]); sum += c; cnt += (c > 0u) ? 1u : 0u; mine = (j == x) ? c : mine; }
    if (sum == G) break;
    __builtin_amdgcn_s_sleep(1);
    if ((++sp & 255u) == 0u) { if (xb_ld(&bar[XB_TMO])) break; if (sp > XB_SPIN_CAP) { atomicAdd(&bar[XB_TMO], 1u); break; } }
  }
  nloc = mine > 0u ? mine : 1u; nx = cnt > 0u ? cnt : 1u;
}
__device__ __forceinline__ void xcd_barrier(const XcdBarrier& b) {
  asm volatile("s_waitcnt vmcnt(0)" ::: "memory");
  __syncthreads();
  if (threadIdx.x == 0) {
    unsigned* bar = b.bar;
    __builtin_amdgcn_s_waitcnt(0);
    unsigned nloc = b.st[0], nx = b.st[1];
    if (nloc == 0u) { xcd_barrier_complete(bar, b.x, nloc, nx); b.st[0] = nloc; b.st[1] = nx; }
    const unsigned old = xb_add(&bar[XB_XSUB(b.x)], 1u);
    const unsigned gen = old / nloc;
    if (old + 1u == (gen + 1u) * nloc) {
      __builtin_amdgcn_fence(__ATOMIC_RELEASE, "agent");
      asm volatile("s_waitcnt vmcnt(0)" ::: "memory");
      const unsigned og = xb_add(&bar[XB_TOP], 1u);
      const unsigned tg = og / nx;
      if (og + 1u == (tg + 1u) * nx) xb_add(&bar[XB_TOPGEN], 1u);
      else XB_SPIN(xb_ld(&bar[XB_TOPGEN]) == tg, bar);
      __builtin_amdgcn_fence(__ATOMIC_ACQUIRE, "agent");
      xb_add(&bar[XB_XGEN(b.x)], 1u);
      asm volatile("s_waitcnt vmcnt(0)" ::: "memory");
    } else {
      XB_SPIN(xb_ld(&bar[XB_XGEN(b.x)]) == gen, bar);
      __builtin_amdgcn_fence(__ATOMIC_ACQUIRE, "agent");
      asm volatile("s_waitcnt vmcnt(0)" ::: "memory");
    }
  }
  __syncthreads();
}

__device__ __forceinline__ void phase_prep(const Params& p, char* smem) {
  const int tid = threadIdx.x, lane = tid & 63, wid = tid >> 6;
  float* tile = (float*)smem;
  u16* WinT = (u16*)((char*)p.out + OOFF_WINT);
  u16* WoutT = (u16*)(p.ws + OFF_WOUTT);
  u16* U = (u16*)((char*)p.out + OOFF_U);
  constexpr int NT_IN = (NPAD / 64) * 16;
  constexpr int NT_OUT = 16 * 32;
  struct TP { const float* src; u16* dst; int src_ld, dst_ld, k0, n0src, n0dst, nvalid; };
  auto tparams = [&](int t) {
    TP q;
    if (t < NT_IN) {
      const int nt = t >> 4, kt = t & 15; q.n0dst = nt * 64; q.k0 = kt * 64;
      if (q.n0dst < 2560) { q.n0src = q.n0dst; q.nvalid = 64; }
      else if (q.n0dst < 6656) { q.n0src = q.n0dst + 16; q.nvalid = 64; }
      else if (q.n0dst == 6656) { q.n0src = 2560; q.nvalid = 16; }
      else { q.n0src = 0; q.nvalid = 0; }
      q.src = p.w_in; q.src_ld = 6672; q.dst = WinT; q.dst_ld = 1024;
    } else {
      const int tt = t - NT_IN, nt = tt >> 5, kt = tt & 31; q.n0dst = nt * 64; q.n0src = q.n0dst; q.nvalid = 64; q.k0 = kt * 64;
      q.src = p.w_out; q.src_ld = 1024; q.dst = WoutT; q.dst_ld = 2048;
    }
    return q;
  };
  float nv[8];
  auto tload = [&](const TP& q) {
#pragma unroll
    for (int i = 0; i < 8; i++) {
      const int r = (tid >> 6) + 8 * i, c = tid & 63;
      nv[i] = (c < q.nvalid) ? q.src[(size_t)(q.k0 + r) * q.src_ld + q.n0src + c] : 0.f;
      if (q.src == p.w_out && q.k0 + r < 1024) nv[i] *= p.ssd_norm_gain[q.k0 + r];
    }
  };
  if (blockIdx.x < NT_IN + NT_OUT) tload(tparams(blockIdx.x));
  for (int t = blockIdx.x; t < NT_IN + NT_OUT; t += gridDim.x) {
    const TP q = tparams(t);
#pragma unroll
    for (int i = 0; i < 8; i++) tile[((tid >> 6) + 8 * i) * 65 + (tid & 63)] = nv[i];
    __syncthreads();
    if (t + (int)gridDim.x < NT_IN + NT_OUT) tload(tparams(t + gridDim.x));
    {
      const int n = tid >> 3, kc = (tid & 7) * 8;
      u32x4 o;
      o.x = pack2(tile[(kc + 0) * 65 + n], tile[(kc + 1) * 65 + n]);
      o.y = pack2(tile[(kc + 2) * 65 + n], tile[(kc + 3) * 65 + n]);
      o.z = pack2(tile[(kc + 4) * 65 + n], tile[(kc + 5) * 65 + n]);
      o.w = pack2(tile[(kc + 6) * 65 + n], tile[(kc + 7) * 65 + n]);
      *(u32x4*)(q.dst + (size_t)(q.n0dst + n) * q.dst_ld + q.k0 + kc) = o;
    }
    __syncthreads();
  }
  for (int row0 = (blockIdx.x * 8 + wid) * 8; row0 < T_; row0 += gridDim.x * 64) {
    float4 v[8][4]; float ss[8];
#pragma unroll
    for (int r = 0; r < 8; r++) {
      const float4* xr = (const float4*)(p.x + (size_t)(row0 + r) * 1024);
#pragma unroll
      for (int i = 0; i < 4; i++) v[r][i] = xr[lane + 64 * i];
    }
#pragma unroll
    for (int r = 0; r < 8; r++) {
      float t = 0.f;
#pragma unroll
      for (int i = 0; i < 4; i++) t += v[r][i].x * v[r][i].x + v[r][i].y * v[r][i].y + v[r][i].z * v[r][i].z + v[r][i].w * v[r][i].w;
      ss[r] = rsqrtf(wave_sum(t) * (1.f / 1024.f) + EPS);
    }
#pragma unroll
    for (int i = 0; i < 4; i++) {
      const float4 g = ((const float4*)p.norm_gain)[lane + 64 * i];
#pragma unroll
      for (int r = 0; r < 8; r++) {
        const float rs = ss[r];
        u32x2 o; o.x = pack2(v[r][i].x * rs * g.x, v[r][i].y * rs * g.y); o.y = pack2(v[r][i].z * rs * g.z, v[r][i].w * rs * g.w);
        *(u32x2*)(U + (size_t)(row0 + r) * 1024 + (lane + 64 * i) * 4) = o;
      }
    }
  }
}

__device__ __forceinline__ float dpp_xor1(float v) {
  return __builtin_bit_cast(float, __builtin_amdgcn_mov_dpp(__builtin_bit_cast(int, v), 0xB1, 0xF, 0xF, true));
}

template <int MODE, int NT, bool SWP>
__device__ __forceinline__ void gemm_tile(const Params& p, char* smem, int m0, int n0) {
  constexpr int KDIM = MODE == 0 ? 1024 : 2048;
  constexpr int KT = KDIM / 64;
  constexpr int LDT = 72;
  constexpr int BROWS = 64 * NT;
  constexpr int WN = 32 * NT;
  u16* As = (u16*)smem;
  u16* Bs = As + 2 * 256 * LDT;
  const int tid = threadIdx.x, lane = tid & 63, w = tid >> 6;
  const int wm = w & 3, wn = w >> 2, r32 = lane & 31, hh = lane >> 5;
  const u16* Wt = MODE == 0 ? (const u16*)((char*)p.out + OOFF_WINT) : (const u16*)(p.ws + OFF_WOUTT);
  const u16* A0 = MODE == 0 ? (const u16*)((char*)p.out + OOFF_U) : (const u16*)(p.ws + OFF_ZS);
  const u16* A1 = (const u16*)(p.ws + OFF_Q);
  const int lrow = tid >> 3, lcc = (tid & 7) * 8;
  f32x16 acc[2][NT];
#pragma unroll
  for (int i = 0; i < 2; i++)
#pragma unroll
    for (int j = 0; j < NT; j++)
#pragma unroll
      for (int r = 0; r < 16; r++) acc[i][j][r] = 0.f;
  u32x4 ra[4], rb[NT];
  const uint32_t aoff0 = (uint32_t)(m0 + lrow) * 2048u + (uint32_t)lcc * 2u;
  const uint32_t boff0 = (uint32_t)(n0 + lrow) * (uint32_t)(KDIM * 2) + (uint32_t)lcc * 2u;
  auto gload = [&](int kt) {
    const char* abase = (const char*)((MODE == 0 || kt < 16) ? A0 : A1);
    const uint32_t ao = aoff0 + (uint32_t)(kt & 15) * 128u;
    const uint32_t bo = boff0 + (uint32_t)kt * 128u;
#pragma unroll
    for (int i = 0; i < 4; i++) ra[i] = *(const u32x4*)(abase + (ao + (uint32_t)i * (64u * 2048u)));
#pragma unroll
    for (int i = 0; i < NT; i++) rb[i] = *(const u32x4*)((const char*)Wt + (bo + (uint32_t)i * (uint32_t)(64 * KDIM * 2)));
  };
  auto lstore = [&](int buf) {
#pragma unroll
    for (int i = 0; i < 4; i++) *(u32x4*)(As + buf * 256 * LDT + (lrow + 64 * i) * LDT + lcc) = ra[i];
#pragma unroll
    for (int i = 0; i < NT; i++) *(u32x4*)(Bs + buf * 256 * LDT + (lrow + 64 * i) * LDT + lcc) = rb[i];
  };
  float rs0[2] = {1.f, 1.f}, rs1[2] = {1.f, 1.f};
  if (MODE == 1 && SWP) {
    const float* RS = (const float*)(p.ws + OFF_RSTD);
#pragma unroll
    for (int i = 0; i < 2; i++) { const float2 r = *(const float2*)(RS + (m0 + wm * 64 + i * 32 + r32) * 2); rs0[i] = r.x * __builtin_amdgcn_rcpf(r.y); rs1[i] = r.y; }
  }
  gload(0); lstore(0);
  __syncthreads();
  for (int kt = 0; kt < KT; kt++) {
    const int buf = kt & 1;
    if (kt + 1 < KT) gload(kt + 1);
    const u16* a_base = As + buf * 256 * LDT + (wm * 64 + r32) * LDT + hh * 8;
    const u16* b_base = Bs + buf * 256 * LDT + (wn * WN + r32) * LDT + hh * 8;
    bf16x8 afb[2][2], bfb[2][NT];
#pragma unroll
    for (int i = 0; i < 2; i++) afb[0][i] = *(const bf16x8*)(a_base + i * 32 * LDT);
#pragma unroll
    for (int j = 0; j < NT; j++) bfb[0][j] = *(const bf16x8*)(b_base + j * 32 * LDT);
#pragma unroll
    for (int ks = 0; ks < 4; ks++) {
      if (ks < 3) {
#pragma unroll
        for (int i = 0; i < 2; i++) afb[(ks + 1) & 1][i] = *(const bf16x8*)(a_base + i * 32 * LDT + (ks + 1) * 16);
#pragma unroll
        for (int j = 0; j < NT; j++) bfb[(ks + 1) & 1][j] = *(const bf16x8*)(b_base + j * 32 * LDT + (ks + 1) * 16);
      }
      const bf16x8 (&af)[2] = afb[ks & 1];
      const bf16x8 (&bfr)[NT] = bfb[ks & 1];
#pragma unroll
      for (int i = 0; i < 2; i++)
#pragma unroll
        for (int j = 0; j < NT; j++) acc[i][j] = SWP ? MFMA32(bfr[j], af[i], acc[i][j]) : MFMA32(af[i], bfr[j], acc[i][j]);
      __builtin_amdgcn_sched_barrier(0);
      if (kt + 1 < KT) {
        u16* an = As + (buf ^ 1) * 256 * LDT + lrow * LDT + lcc;
        u16* bn = Bs + (buf ^ 1) * 256 * LDT + lrow * LDT + lcc;
        if (ks == 1) { *(u32x4*)(an) = ra[0]; *(u32x4*)(an + 64 * LDT) = ra[1]; *(u32x4*)(an + 128 * LDT) = ra[2]; }
        if (ks == 2) { *(u32x4*)(an + 192 * LDT) = ra[3]; *(u32x4*)(bn) = rb[0]; *(u32x4*)(bn + 64 * LDT) = rb[1]; }
        if (ks == 3 && NT == 4) { *(u32x4*)(bn + 128 * LDT) = rb[NT - 2]; *(u32x4*)(bn + 192 * LDT) = rb[NT - 1]; }
      }
    }
    if (MODE == 1 && SWP && (kt == 7 || kt == 15)) {
#pragma unroll
      for (int i = 0; i < 2; i++) {
        const float sc = (kt == 7) ? rs0[i] : rs1[i];
#pragma unroll
        for (int j = 0; j < NT; j++)
#pragma unroll
          for (int r = 0; r < 16; r++) acc[i][j][r] *= sc;
      }
    }
    __syncthreads();
  }
  if (SWP) {
    const int row0 = m0 + wm * 64 + r32;
    if (MODE == 0) {
      if (n0 == 6656) {
        if (wn == 0) {
          float* DT = (float*)(p.ws + OFF_DT);
#pragma unroll
          for (int mt = 0; mt < 2; mt++)
#pragma unroll
            for (int g = 0; g < 2; g++) {
              const int c0 = 8 * g + 4 * hh;
              const float4 bias = *(const float4*)(p.dt_bias + c0);
              float4 o;
              { const float v = acc[mt][0][4 * g + 0] + bias.x; o.x = fmaxf(v, 0.f) + log1pf(__expf(-fabsf(v))); }
              { const float v = acc[mt][0][4 * g + 1] + bias.y; o.y = fmaxf(v, 0.f) + log1pf(__expf(-fabsf(v))); }
              { const float v = acc[mt][0][4 * g + 2] + bias.z; o.z = fmaxf(v, 0.f) + log1pf(__expf(-fabsf(v))); }
              { const float v = acc[mt][0][4 * g + 3] + bias.w; o.w = fmaxf(v, 0.f) + log1pf(__expf(-fabsf(v))); }
              *(float4*)(DT + (row0 + mt * 32) * 16 + c0) = o;
            }
        }
      } else if (n0 >= 4608 && n0 < 5632) {
        u16* VT = (u16*)(p.ws + OFF_VT);
        const int q4 = lane & 3;
        const bool q1 = q4 & 1, q2 = q4 & 2;
#pragma unroll
        for (int mt = 0; mt < 2; mt++) {
          const int t0 = (row0 + mt * 32) & ~3;
          const uint32_t tb = ((uint32_t)((t0 >> 13) * 1024 + (n0 - 4608 + wn * WN + 4 * hh + q4)) * 8192u + (uint32_t)(t0 & 8191)) * 2u;
#pragma unroll
          for (int nt = 0; nt < NT; nt++)
#pragma unroll
            for (int g = 0; g < 4; g++) {
              const float a0 = acc[mt][nt][4 * g + 0], a1 = acc[mt][nt][4 * g + 1], a2 = acc[mt][nt][4 * g + 2], a3 = acc[mt][nt][4 * g + 3];
              const float r1 = dpp_xor1(q1 ? a0 : a1), r3 = dpp_xor1(q1 ? a2 : a3);
              const uint32_t p01 = q1 ? pack2(r1, a1) : pack2(a0, r1);
              const uint32_t p23 = q1 ? pack2(r3, a3) : pack2(a2, r3);
              const uint32_t rx = (uint32_t)__builtin_amdgcn_mov_dpp((int)(q2 ? p01 : p23), 0x4E, 0xF, 0xF, true);
              u32x2 o; o.x = q2 ? rx : p01; o.y = q2 ? p23 : rx;
              *(u32x2*)((char*)VT + (tb + (uint32_t)(nt * 32 + 8 * g) * 16384u)) = o;
            }
        }
      } else {
        u16* dst; int ld, coff; float scale = 1.f;
        if (n0 < 1024) { dst = (u16*)(p.ws + OFF_ZS); ld = 1024; coff = 0; }
        else if (n0 < 2560) { dst = (u16*)(p.ws + OFF_XBC); ld = 1536; coff = 1024; }
        else if (n0 < 3584) { dst = (u16*)(p.ws + OFF_Q); ld = 1024; coff = 2560; scale = 0.125f * LOG2E; }
        else if (n0 < 4608) { dst = (u16*)(p.ws + OFF_K); ld = 1024; coff = 3584; }
        else { dst = (u16*)(p.ws + OFF_ZA); ld = 1024; coff = 5632; }
#pragma unroll
        for (int mt = 0; mt < 2; mt++) {
          const uint32_t rowb = ((uint32_t)(row0 + mt * 32) * (uint32_t)ld + (uint32_t)(n0 + wn * WN - coff + (hh ? 8 : 0))) * 2u;
#pragma unroll
          for (int nt = 0; nt < NT; nt++)
#pragma unroll
            for (int k = 0; k < 4; k += 2) {
              uint32_t ax = pack2(acc[mt][nt][4 * k + 0] * scale, acc[mt][nt][4 * k + 1] * scale);
              uint32_t ay = pack2(acc[mt][nt][4 * k + 2] * scale, acc[mt][nt][4 * k + 3] * scale);
              uint32_t bx = pack2(acc[mt][nt][4 * k + 4] * scale, acc[mt][nt][4 * k + 5] * scale);
              uint32_t by = pack2(acc[mt][nt][4 * k + 6] * scale, acc[mt][nt][4 * k + 7] * scale);
              { auto r = __builtin_amdgcn_permlane32_swap(ax, bx, false, false); ax = r[0]; bx = r[1]; }
              { auto r = __builtin_amdgcn_permlane32_swap(ay, by, false, false); ay = r[0]; by = r[1]; }
              u32x4 o; o.x = ax; o.y = ay; o.z = bx; o.w = by;
              *(u32x4*)((char*)dst + (rowb + (uint32_t)((nt * 32 + 8 * k) * 2))) = o;
            }
        }
        if (n0 >= 3584 && n0 < 4608) {
#pragma unroll
          for (int grp = 0; grp < NT / 2; grp++) {
            float mx = 0.f;
#pragma unroll
            for (int mt = 0; mt < 2; mt++) {
              float v = 0.f;
#pragma unroll
              for (int reg = 0; reg < 16; reg++) v += acc[mt][2 * grp][reg] * acc[mt][2 * grp][reg] + acc[mt][2 * grp + 1][reg] * acc[mt][2 * grp + 1][reg];
              v += __shfl_xor(v, 32);
              mx = fmaxf(mx, v);
            }
#pragma unroll
            for (int o = 1; o < 32; o <<= 1) mx = fmaxf(mx, __shfl_xor(mx, o));
            if (lane == 0) atomicMax((unsigned int*)(p.ws + OFF_KMAX) + (m0 >> 13) * 16 + ((n0 - 3584 + wn * WN + grp * 64) >> 6), __float_as_uint(mx));
          }
        }
      }
    } else {
#pragma unroll
      for (int mt = 0; mt < 2; mt++) {
        const uint32_t rowb = ((uint32_t)(row0 + mt * 32) * 1024u + (uint32_t)(n0 + wn * WN + 4 * hh)) * 4u;
#pragma unroll
        for (int nt = 0; nt < NT; nt++)
#pragma unroll
          for (int g = 0; g < 4; g++) {
            const uint32_t idx = rowb + (uint32_t)((nt * 32 + 8 * g) * 4);
            const float4 xv = *(const float4*)((const char*)p.x + idx);
            float4 o;
            o.x = xv.x + acc[mt][nt][4 * g + 0]; o.y = xv.y + acc[mt][nt][4 * g + 1];
            o.z = xv.z + acc[mt][nt][4 * g + 2]; o.w = xv.w + acc[mt][nt][4 * g + 3];
            *(float4*)((char*)p.out + idx) = o;
          }
      }
    }
    return;
  }
  const int rbase = m0 + wm * 64 + 4 * hh;
  const int cbase = n0 + wn * WN + r32;
  const bool odd = lane & 1;
  if (MODE == 0) {
    if (n0 >= 4608 && n0 < 5632) {
      u16* VT = (u16*)(p.ws + OFF_VT);
#pragma unroll
      for (int mt = 0; mt < 2; mt++)
#pragma unroll
        for (int nt = 0; nt < NT; nt++)
#pragma unroll
          for (int rg = 0; rg < 4; rg++) {
            const int row0 = rbase + mt * 32 + 8 * rg;
            const int c = cbase + nt * 32 - 4608;
            const int bb = row0 >> 13, sq = row0 & 8191;
            u32x2 o; o.x = pack2(acc[mt][nt][rg * 4 + 0], acc[mt][nt][rg * 4 + 1]); o.y = pack2(acc[mt][nt][rg * 4 + 2], acc[mt][nt][rg * 4 + 3]);
            *(u32x2*)((char*)VT + ((uint32_t)(bb * 1024 + c) * 8192u + (uint32_t)sq) * 2u) = o;
          }
    } else if (NT == 2 && n0 == 6656) {
      if (wn == 0 && r32 < 16) {
        float* DT = (float*)(p.ws + OFF_DT);
        const float bias = p.dt_bias[r32];
#pragma unroll
        for (int mt = 0; mt < 2; mt++)
#pragma unroll
          for (int reg = 0; reg < 16; reg++) {
            const int row = rbase + mt * 32 + (reg & 3) + 8 * (reg >> 2);
            const float v = acc[mt][0][reg] + bias;
            DT[row * 16 + r32] = fmaxf(v, 0.f) + log1pf(__expf(-fabsf(v)));
          }
      }
    } else {
      u16* dst; int ld, coff; float scale = 1.f;
      if (n0 < 1024) { dst = (u16*)(p.ws + OFF_ZS); ld = 1024; coff = 0; }
      else if (n0 < 2560) { dst = (u16*)(p.ws + OFF_XBC); ld = 1536; coff = 1024; }
      else if (n0 < 3584) { dst = (u16*)(p.ws + OFF_Q); ld = 1024; coff = 2560; scale = 0.125f * LOG2E; }
      else if (n0 < 4608) { dst = (u16*)(p.ws + OFF_K); ld = 1024; coff = 3584; }
      else { dst = (u16*)(p.ws + OFF_ZA); ld = 1024; coff = 5632; }
#pragma unroll
      for (int mt = 0; mt < 2; mt++)
#pragma unroll
        for (int nt = 0; nt < NT; nt++)
#pragma unroll
          for (int t = 0; t < 8; t++) {
            const float va = acc[mt][nt][2 * t] * scale, vb = acc[mt][nt][2 * t + 1] * scale;
            const float recv = dpp_xor1(odd ? va : vb);
            const int reg = 2 * t + (odd ? 1 : 0);
            const int row = rbase + mt * 32 + (reg & 3) + 8 * (reg >> 2);
            const int col = ((cbase + nt * 32) & ~1) - coff;
            *(uint32_t*)((char*)dst + ((uint32_t)row * (uint32_t)ld + (uint32_t)col) * 2u) = odd ? pack2(recv, vb) : pack2(va, recv);
          }
      if (n0 >= 3584 && n0 < 4608) {
#pragma unroll
        for (int grp = 0; grp < NT / 2; grp++) {
          float mx = 0.f;
#pragma unroll
          for (int mt = 0; mt < 2; mt++)
#pragma unroll
            for (int reg = 0; reg < 16; reg++) {
              float v = acc[mt][2 * grp][reg] * acc[mt][2 * grp][reg] + acc[mt][2 * grp + 1][reg] * acc[mt][2 * grp + 1][reg];
#pragma unroll
              for (int o = 1; o < 32; o <<= 1) v += __shfl_xor(v, o);
              mx = fmaxf(mx, v);
            }
          mx = fmaxf(mx, __shfl_xor(mx, 32));
          if (lane == 0) atomicMax((unsigned int*)(p.ws + OFF_KMAX) + (m0 >> 13) * 16 + ((n0 - 3584 + wn * WN + grp * 64) >> 6), __float_as_uint(mx));
        }
      }
    }
  } else {
#pragma unroll
    for (int mt = 0; mt < 2; mt++)
#pragma unroll
      for (int nt = 0; nt < NT; nt++)
#pragma unroll
        for (int t = 0; t < 8; t++) {
          const float va = acc[mt][nt][2 * t], vb = acc[mt][nt][2 * t + 1];
          const float recv = dpp_xor1(odd ? va : vb);
          const int reg = 2 * t + (odd ? 1 : 0);
          const int row = rbase + mt * 32 + (reg & 3) + 8 * (reg >> 2);
          const int col = (cbase + nt * 32) & ~1;
          const uint32_t idx = ((uint32_t)row * 1024u + (uint32_t)col) * 4u;
          const float2 xv = *(const float2*)((const char*)p.x + idx);
          float2 o;
          o.x = xv.x + (odd ? recv : va); o.y = xv.y + (odd ? vb : recv);
          *(float2*)((char*)p.out + idx) = o;
        }
  }
}

__device__ __forceinline__ void dt_piece(const Params& p, char* smem, int m0) {
  const int tid = threadIdx.x, lane = tid & 63, w = tid >> 6, r32 = lane & 31, hh = lane >> 5;
  const u16* U = (const u16*)((const char*)p.out + OOFF_U);
  const u16* Wd = (const u16*)((const char*)p.out + OOFF_WINT) + (size_t)6656 * 1024;
  float* red = (float*)smem;
  f32x16 acc[2];
#pragma unroll
  for (int i = 0; i < 2; i++)
#pragma unroll
    for (int r = 0; r < 16; r++) acc[i][r] = 0.f;
  bf16x8 af[2][8], bfr[8];
  const int kb = w * 128 + hh * 8;
#pragma unroll
  for (int ks = 0; ks < 8; ks++) {
    bfr[ks] = *(const bf16x8*)(Wd + (size_t)r32 * 1024 + kb + ks * 16);
#pragma unroll
    for (int i = 0; i < 2; i++) af[i][ks] = *(const bf16x8*)(U + (size_t)(m0 + i * 32 + r32) * 1024 + kb + ks * 16);
  }
#pragma unroll
  for (int ks = 0; ks < 8; ks++)
#pragma unroll
    for (int i = 0; i < 2; i++) acc[i] = MFMA32(af[i][ks], bfr[ks], acc[i]);
  __syncthreads();
#pragma unroll
  for (int i = 0; i < 2; i++)
#pragma unroll
    for (int reg = 0; reg < 16; reg++)
      red[(w * 64 + i * 32 + (reg & 3) + 8 * (reg >> 2) + 4 * hh) * 32 + r32] = acc[i][reg];
  __syncthreads();
  float* DT = (float*)(p.ws + OFF_DT);
#pragma unroll
  for (int o = tid; o < 1024; o += 512) {
    const int row = o >> 4, col = o & 15;
    float v = p.dt_bias[col];
#pragma unroll
    for (int ww = 0; ww < 8; ww++) v += red[(ww * 64 + row) * 32 + col];
    DT[(m0 + row) * 16 + col] = fmaxf(v, 0.f) + log1pf(__expf(-fabsf(v)));
  }
  __syncthreads();
}

template <int MODE>
__device__ __forceinline__ void gemm_phase(const Params& p, char* smem, bool dry, int vbid) {
  (void)dry;
  const int bid = vbid;
  if (gridDim.x == 256) {
    const int x = bid & 7, j = bid >> 3;
    const int m0 = (x * 8 + (j & 7)) * 256, nq = j >> 3;
    if (MODE == 0) {
#pragma unroll 1
      for (int r = 0; r < 6; r++) {
        const int n0 = (r * 4 + nq) * 256;
        gemm_tile<0, 4, false>(p, smem, m0, n0);
      }
      gemm_tile<0, 2, false>(p, smem, m0, 6144 + nq * 128);
      dt_piece(p, smem, (int)blockIdx.x * 64);
    } else {
      gemm_tile<1, 4, true>(p, smem, m0, nq * 256);
    }
  } else {
    constexpr int NTN = MODE == 0 ? 53 : 8;
    for (int tile = bid; tile < 64 * NTN; tile += gridDim.x) {
      const int n0 = (tile >> 6) * 128;
      gemm_tile<MODE, 2, MODE == 1>(p, smem, (tile & 63) * 256, n0);
    }
  }
}

template <typename F>
__device__ __forceinline__ void conv_run32(const u16* xbc0, int col, bool first_chunk, int l0, const float* cw, const float* cb, F f) {
  const float w0 = cw[col], w1 = cw[1536 + col], w2 = cw[2 * 1536 + col], w3 = cw[3 * 1536 + col], bias = cb[col];
  float u[35];
#pragma unroll
  for (int i = 0; i < 35; i++) {
    const int l = l0 - 3 + i;
    u[i] = (first_chunk && l < 0) ? 0.f : bf2f((uint32_t)xbc0[(ptrdiff_t)l * 1536 + col]);
  }
#pragma unroll
  for (int i = 0; i < 32; i++) {
    const float v = w0 * u[i] + w1 * u[i + 1] + w2 * u[i + 2] + w3 * u[i + 3] + bias;
    f(i, silu(v));
  }
}

__device__ __forceinline__ void phase_states(const Params& p, char* smem) {
  u16* BT = (u16*)smem;
  u16* XT = BT + 128 * 136;
  float* wl = (float*)(XT + 2 * 64 * 136);
  const int tid = threadIdx.x, lane = tid & 63, w = tid >> 6, r32 = lane & 31, hh = lane >> 5;
  const int hg = w >> 2, wq = w & 3;
  const u16* XBC = (const u16*)(p.ws + OFF_XBC);
  const float* DT = (const float*)(p.ws + OFF_DT);
  float* CD = (float*)(p.ws + OFF_CD);
  u16* ST = (u16*)p.out;
  for (int item = blockIdx.x; item < 256; item += gridDim.x) {
    const int g = item & 1, bc = item >> 1, c = bc & 63, b = bc >> 6;
    const int tok0 = b * 8192 + c * 128;
    const u16* xbc0 = XBC + (size_t)tok0 * 1536;
    {
      const int h = g * 8 + w;
      const float v0 = DT[(tok0 + 2 * lane) * 16 + h], v1 = DT[(tok0 + 2 * lane + 1) * 16 + h];
      float sc = v0 + v1;
#pragma unroll
      for (int d = 1; d < 64; d <<= 1) { float t = __shfl_up(sc, d); if (lane >= d) sc += t; }
      const float A = -__expf(p.a_log[h]);
      const float tot = __shfl(sc, 63);
      const float e = sc - (v0 + v1);
      wl[w * 128 + 2 * lane] = v0 * __expf(A * (tot - (e + v0)));
      wl[w * 128 + 2 * lane + 1] = v1 * __expf(A * (tot - sc));
      if (lane == 0) CD[bc * 16 + h] = __expf(A * tot);
    }
    {
      const int ch = tid & 127, q = tid >> 7;
      u16* dst = BT + ch * 136 + q * 32;
      uint32_t pk[16];
      conv_run32(xbc0, 1024 + g * 128 + ch, c == 0, q * 32, p.conv_w, p.conv_b, [&](int i, float v) {
        const uint32_t hb = f2bf(v);
        if (i & 1) pk[i >> 1] |= hb << 16; else pk[i >> 1] = hb;
      });
#pragma unroll
      for (int j = 0; j < 4; j++) { u32x4 o; o.x = pk[4 * j]; o.y = pk[4 * j + 1]; o.z = pk[4 * j + 2]; o.w = pk[4 * j + 3]; *(u32x4*)(dst + 8 * j) = o; }
    }
    for (int hi = 0; hi < 4; hi++) {
      const int hl = hg * 4 + hi, h = g * 8 + hl;
      __syncthreads();
      {
        const int t = tid & 255, ch = t & 63, q = t >> 6;
        u16* dst = XT + hg * 64 * 136 + ch * 136 + q * 32;
        const float* wlh = wl + hl * 128 + q * 32;
        uint32_t pk[16], pg[16];
        float pv = 0.f, ps = 0.f;
        conv_run32(xbc0, h * 64 + ch, c == 0, q * 32, p.conv_w, p.conv_b, [&](int i, float v) {
          const float sc = v * wlh[i];
          if (i & 1) { pk[i >> 1] = pack2(ps, sc); pg[i >> 1] = pack2(pv, v); } else { pv = v; ps = sc; }
        });
        u16* dstg = (u16*)((char*)p.out + OOFF_XTG) + ((size_t)(bc * 16 + h) * 64 + ch) * 128 + q * 32;
#pragma unroll
        for (int j = 0; j < 4; j++) {
          u32x4 o; o.x = pk[4 * j]; o.y = pk[4 * j + 1]; o.z = pk[4 * j + 2]; o.w = pk[4 * j + 3]; *(u32x4*)(dst + 8 * j) = o;
          u32x4 og; og.x = pg[4 * j]; og.y = pg[4 * j + 1]; og.z = pg[4 * j + 2]; og.w = pg[4 * j + 3]; *(u32x4*)(dstg + 8 * j) = og;
        }
      }
      __syncthreads();
      {
        const u16* xt = XT + hg * 64 * 136;
        f32x16 acc[2];
#pragma unroll
        for (int mt = 0; mt < 2; mt++)
#pragma unroll
          for (int r = 0; r < 16; r++) acc[mt][r] = 0.f;
#pragma unroll
        for (int ks = 0; ks < 8; ks++) {
          const bf16x8 bb = *(const bf16x8*)(BT + (wq * 32 + r32) * 136 + ks * 16 + hh * 8);
#pragma unroll
          for (int mt = 0; mt < 2; mt++) {
            const bf16x8 a = *(const bf16x8*)(xt + (mt * 32 + r32) * 136 + ks * 16 + hh * 8);
            acc[mt] = MFMA32(a, bb, acc[mt]);
          }
        }
        u16* dst = ST + ((size_t)(bc * 16 + h) * 64) * 128;
#pragma unroll
        for (int mt = 0; mt < 2; mt++)
#pragma unroll
          for (int reg = 0; reg < 16; reg++) {
            const int pp = mt * 32 + (reg & 3) + 8 * (reg >> 2) + 4 * hh;
            dst[pp * 128 + wq * 32 + r32] = f2bf(acc[mt][reg]);
          }
      }
    }
    __syncthreads();
  }
}

__device__ __forceinline__ void phase_scan(const Params& p) {
  const u16* ST = (const u16*)p.out;
  const float* CD = (const float*)(p.ws + OFF_CD);
  u16* PREV = (u16*)(p.ws + OFF_PREV);
  for (int idx = blockIdx.x * 512 + threadIdx.x; idx < 131072; idx += gridDim.x * 512) {
    const int e = idx * 2;
    const int b = e >> 17, rem = e & 131071, h = rem >> 13;
    float hx = 0.f, hy = 0.f;
#pragma unroll 32
    for (int c = 0; c < 64; c++) {
      const size_t off = (size_t)(b * 64 + c) * 131072 + rem;
      const uint32_t sw = *(const uint32_t*)(ST + off);
      float2 s; s.x = bflo(sw); s.y = bfhi(sw);
      const float d = CD[(b * 64 + c) * 16 + h];
      *(uint32_t*)(PREV + off) = pack2(hx, hy);
      hx = hx * d + s.x; hy = hy * d + s.y;
    }
  }
}

__device__ __forceinline__ void ssd_out_item(const Params& p, char* smem, int item, bool dry) {
  const int g = item & 1, bc = item >> 1, c = bc & 63, b = bc >> 6;
  const int tok0 = b * 8192 + c * 128;
  u16* R1 = (u16*)smem;
  u16* R2 = R1 + 128 * 136;
  u16* XT = R2 + 128 * 136;
  float* dts = (float*)(XT + 2 * 64 * 136);
  float* acs = dts + 1024;
  float* part = acs + 1024;
  float* rstd = part + 256;
  u16* PVB = (u16*)(rstd + 128);
  const int tid = threadIdx.x, lane = tid & 63, w = tid >> 6, r32 = lane & 31, hh = lane >> 5;
  const int lt = w & 3, hg = w >> 2;
  const u16* xbc0 = (const u16*)(p.ws + OFF_XBC) + (size_t)tok0 * 1536;
  const float* DT = (const float*)(p.ws + OFF_DT);
  u16* ZS = (u16*)(p.ws + OFF_ZS);
  const u16* PREV = (const u16*)(p.ws + OFF_PREV);
  const bool first = (c == 0);
  {
    const int h = g * 8 + w;
    const float v0 = DT[(tok0 + 2 * lane) * 16 + h], v1 = DT[(tok0 + 2 * lane + 1) * 16 + h];
    float sc = v0 + v1;
#pragma unroll
    for (int d = 1; d < 64; d <<= 1) { float t = __shfl_up(sc, d); if (lane >= d) sc += t; }
    const float A = -__expf(p.a_log[h]);
    const float e = sc - (v0 + v1);
    dts[w * 128 + 2 * lane] = v0; dts[w * 128 + 2 * lane + 1] = v1;
    acs[w * 128 + 2 * lane] = A * (e + v0); acs[w * 128 + 2 * lane + 1] = A * sc;
  }
  {
    const int ch = tid & 127, q = tid >> 7;
    conv_run32(xbc0, 1280 + g * 128 + ch, first, q * 32, p.conv_w, p.conv_b, [&](int i, float v) { R1[(q * 32 + i) * 136 + ch] = f2bf(v); });
    conv_run32(xbc0, 1024 + g * 128 + ch, first, q * 32, p.conv_w, p.conv_b, [&](int i, float v) { R2[(q * 32 + i) * 136 + ch] = f2bf(v); });
  }
  __syncthreads();
  const u16* cfp = R1 + (lt * 32 + r32) * 136 + hh * 8;
  float ss[16];
#pragma unroll
  for (int r = 0; r < 16; r++) ss[r] = 0.f;
  u32x4 xr[4];
  {
    const char* src = (const char*)p.out + OOFF_XTG + (size_t)(bc * 16 + g * 8 + hg * 4) * 16384;
#pragma unroll
    for (int i = 0; i < 4; i++) xr[i] = *(const u32x4*)(src + ((tid & 255) + 256 * i) * 16);
  }
  for (int hi = 0; hi < 4; hi++) {
    const int h = g * 8 + hg * 4 + hi;
    __syncthreads();
    {
      const int t = tid & 255;
      u16* dstb = XT + hg * 64 * 136;
#pragma unroll
      for (int i = 0; i < 4; i++) {
        const int id = t + 256 * i, row = id >> 4, cc = id & 15;
        *(u32x4*)(dstb + row * 136 + cc * 8) = xr[i];
        *(u32x4*)(PVB + hg * 64 * 136 + row * 136 + cc * 8) = *(const u32x4*)((const char*)PREV + (size_t)(bc * 16 + h) * 16384 + id * 16);
      }
    }
    __syncthreads();
    if (hi < 3) {
      const char* src = (const char*)p.out + OOFF_XTG + (size_t)(bc * 16 + h + 1) * 16384;
#pragma unroll
      for (int i = 0; i < 4; i++) xr[i] = *(const u32x4*)(src + ((tid & 255) + 256 * i) * 16);
    }
    const float* acs_h = acs + (hg * 4 + hi) * 128;
    const float* dts_h = dts + (hg * 4 + hi) * 128;
    const u16* xt = XT + hg * 64 * 136;
    f32x16 acc[2];
#pragma unroll
    for (int pt = 0; pt < 2; pt++)
#pragma unroll
      for (int r = 0; r < 16; r++) acc[pt][r] = 0.f;
    const uint32_t zoff0 = ((uint32_t)(tok0 + lt * 32 + 4 * hh) * 1024u + (uint32_t)(h * 64 + r32)) * 2u;
    u16 zraw[2][16];
#pragma unroll
    for (int reg = 0; reg < 16; reg++)
      zraw[0][reg] = *(const u16*)((const char*)ZS + (zoff0 + (uint32_t)(((reg & 3) + 8 * (reg >> 2)) * 2048)));
    const u16* prev_h = PVB + hg * 64 * 136;
#pragma unroll
    for (int ks = 0; ks < 8; ks++)
#pragma unroll
      for (int pt = 0; pt < 2; pt++) {
        bf16x8 bfr = *(const bf16x8*)(prev_h + (pt * 32 + r32) * 136 + ks * 16 + hh * 8);
        acc[pt] = MFMA32(*(const bf16x8*)(cfp + ks * 16), bfr, acc[pt]);
      }
#pragma unroll
    for (int reg = 0; reg < 16; reg++) {
      const float e = __expf(acs_h[lt * 32 + (reg & 3) + 8 * (reg >> 2) + 4 * hh]);
      acc[0][reg] *= e; acc[1][reg] *= e;
    }
    const int lcol = lt * 32 + r32;
    const float acs_l = acs_h[lcol];
#pragma unroll 1
    for (int st = 0; st <= lt; st++) {
      {
        f32x16 Xs;
#pragma unroll
        for (int r = 0; r < 16; r++) Xs[r] = 0.f;
#pragma unroll
        for (int ks = 0; ks < 8; ks++) {
          bf16x8 a = *(const bf16x8*)(R2 + (st * 32 + r32) * 136 + ks * 16 + hh * 8);
          Xs = MFMA32(a, *(const bf16x8*)(cfp + ks * 16), Xs);
        }
#pragma unroll
        for (int sp = 0; sp < 2; sp++) {
          __builtin_amdgcn_sched_barrier(0);
          float gv[8];
#pragma unroll
          for (int j = 0; j < 8; j++) {
            const int reg = 8 * sp + j;
            const int s = st * 32 + (reg & 3) + 8 * (reg >> 2) + 4 * hh;
            const float v = Xs[reg] * __expf(acs_l - acs_h[s]) * dts_h[s];
            gv[j] = (s <= lcol) ? v : 0.f;
          }
          u32x4 aw; aw.x = pack2(gv[0], gv[1]); aw.y = pack2(gv[2], gv[3]); aw.z = pack2(gv[4], gv[5]); aw.w = pack2(gv[6], gv[7]);
          const bf16x8 af = __builtin_bit_cast(bf16x8, aw);
#pragma unroll
          for (int pt = 0; pt < 2; pt++) {
            const u16* xp = xt + (pt * 32 + r32) * 136 + st * 32 + sp * 16 + hh * 4;
            const u32x2 lo = *(const u32x2*)xp, hi2 = *(const u32x2*)(xp + 8);
            u32x4 bw; bw.x = lo.x; bw.y = lo.y; bw.z = hi2.x; bw.w = hi2.y;
            acc[pt] = MFMA32(af, __builtin_bit_cast(bf16x8, bw), acc[pt]);
          }
        }
      }
    }
    const float dsk = p.d_skip[h];
#pragma unroll
    for (int reg = 0; reg < 16; reg++)
      zraw[1][reg] = *(const u16*)((const char*)ZS + (zoff0 + (uint32_t)(((reg & 3) + 8 * (reg >> 2)) * 2048 + 64)));
#pragma unroll
    for (int pt = 0; pt < 2; pt++)
#pragma unroll
      for (int rg = 0; rg < 4; rg++) {
        __builtin_amdgcn_sched_barrier(0);
        const u32x2 xv = *(const u32x2*)(xt + (pt * 32 + r32) * 136 + lt * 32 + 8 * rg + 4 * hh);
#pragma unroll
        for (int i = 0; i < 4; i++) {
          const int reg = rg * 4 + i;
          const int l = lt * 32 + 8 * rg + 4 * hh + i;
          const uint32_t xw = (i < 2) ? xv.x : xv.y;
          const float xval = (i & 1) ? bfhi(xw) : bflo(xw);
          const float y = acc[pt][reg] + dsk * xval;
          const float z = bf2f((uint32_t)zraw[pt][reg]);
          const float t = y * silu(z);
          ss[reg] += t * t;
          if (!dry) *(u16*)((char*)ZS + (zoff0 + (uint32_t)(((reg & 3) + 8 * (reg >> 2)) * 2048 + pt * 64))) = f2bf(t);
        }
      }
  }
#pragma unroll
  for (int reg = 0; reg < 16; reg++) {
    float v = ss[reg];
#pragma unroll
    for (int o = 1; o < 32; o <<= 1) v += __shfl_xor(v, o);
    if (r32 == 0) part[hg * 128 + lt * 32 + (reg & 3) + 8 * (reg >> 2) + 4 * hh] = v;
  }
  __syncthreads();
  if (tid < 128 && !dry) ((float*)(p.ws + OFF_RSTD))[(tok0 + tid) * 2 + g] = rsqrtf((part[tid] + part[128 + tid]) * (1.f / 512.f) + EPS);
  __syncthreads();
}

__device__ __forceinline__ void attn_item(const Params& p, char* smem, int item, float lam, bool dry, int* qctr, int* s_next) {
  const int h = 7 - (item >> 7), qb = 63 - ((item & 127) >> 1), b = item & 1, bh = b * 8 + h;
  constexpr int KVSTAGE = 64 * 136 + 128 * 72;
  u16* KV = (u16*)smem;
  float* ex = (float*)(KV + 2 * KVSTAGE);
  const int tid = threadIdx.x, lane = tid & 63, w = tid >> 6, r32 = lane & 31, hh = lane >> 5;
  const int qt = w & 3, m = w >> 2;
  const int qpos0 = qb * 128 + qt * 32, qpos = qpos0 + r32;
  const float slope2 = __builtin_amdgcn_exp2f(-(float)(h + 1)) * LOG2E;
  const u16* Qb = (const u16*)(p.ws + OFF_Q);
  const u16* Kb = (const u16*)(p.ws + OFF_K) + (size_t)(b * 8192) * 1024 + h * 128;
  const u16* Vb = (const u16*)(p.ws + OFF_VT) + (size_t)(bh * 128) * 8192;
  u32x4 rk[2], rv[2];
  auto gload = [&](int kt) {
    const int J0 = kt * 64;
#pragma unroll
    for (int i = 0; i < 2; i++) {
      const int id = tid + 512 * i;
      rk[i] = *(const u32x4*)(Kb + (size_t)(J0 + (id >> 4)) * 1024 + (id & 15) * 8);
      rv[i] = *(const u32x4*)(Vb + (size_t)(id >> 3) * 8192 + J0 + (id & 7) * 8);
    }
  };
  auto lstore = [&](int stage) {
    u16* Ks = KV + stage * KVSTAGE;
    u16* Vs = Ks + 64 * 136;
#pragma unroll
    for (int i = 0; i < 2; i++) {
      const int id = tid + 512 * i;
      *(u32x4*)(Ks + (id >> 4) * 136 + (id & 15) * 8) = rk[i];
      u32x2 v0, v1; v0.x = rv[i].x; v0.y = rv[i].y; v1.x = rv[i].z; v1.y = rv[i].w;
      u16* vd = Vs + (id >> 3) * 72 + ((id & 7) >> 1) * 16 + ((id & 1) ? 4 : 0);
      *(u32x2*)(vd) = v0;
      *(u32x2*)(vd + 8) = v1;
    }
  };
  const int nkt = 2 * qb + 2;
  gload(nkt - 1);
  bf16x8 qf[4];
  {
    const u16* qptr = Qb + (size_t)(b * 8192 + qpos) * 1024 + h * 128 + m * 64 + hh * 8;
#pragma unroll
    for (int ks = 0; ks < 4; ks++) qf[ks] = *(const bf16x8*)(qptr + ks * 16);
  }
  float bound2;
  {
    float qn2 = 0.f;
#pragma unroll
    for (int ks = 0; ks < 4; ks++) {
      const u32x4 qw = __builtin_bit_cast(u32x4, qf[ks]);
      qn2 += bflo(qw.x) * bflo(qw.x) + bfhi(qw.x) * bfhi(qw.x) + bflo(qw.y) * bflo(qw.y) + bfhi(qw.y) * bfhi(qw.y);
      qn2 += bflo(qw.z) * bflo(qw.z) + bfhi(qw.z) * bfhi(qw.z) + bflo(qw.w) * bflo(qw.w) + bfhi(qw.w) * bfhi(qw.w);
    }
    qn2 += __shfl_xor(qn2, 32);
    const float kmax2 = __uint_as_float(((const unsigned int*)(p.ws + OFF_KMAX))[bh * 2 + m]);
    bound2 = sqrtf(qn2 * kmax2) * 1.02f;
  }
  bool wdone = false, first = true, fast = false;
  f32x16 O[4];
#pragma unroll
  for (int d = 0; d < 4; d++)
#pragma unroll
    for (int r = 0; r < 16; r++) O[d][r] = 0.f;
  float mrow = -INFINITY, lsum = 0.f;
  lstore((nkt - 1) & 1);
  __syncthreads();
  if (__builtin_amdgcn_readfirstlane(threadIdx.x) >= 256) __builtin_amdgcn_s_setprio(1);
  for (int kt = nkt - 1; kt >= 0; kt--) {
    const int J0 = kt * 64;
    const u16* Ks = KV + (kt & 1) * KVSTAGE;
    const u16* Vs = Ks + 64 * 136;
    if (kt > 0) gload(kt - 1);
    if (fast && !wdone && J0 + 64 <= qpos0) {
      const float base1 = slope2 * (float)(J0 + 32 + 4 * hh - qpos) - mrow;
      const float base0 = base1 - 32.f * slope2;
      f32x16 S1, S0;
#pragma unroll
      for (int reg = 0; reg < 16; reg++) {
        const float c = (float)((reg & 3) + 8 * (reg >> 2));
        S1[reg] = fmaf(slope2, c, base1);
        S0[reg] = fmaf(slope2, c, base0);
      }
#pragma unroll
      for (int ks = 0; ks < 4; ks++) {
        const bf16x8 k1 = *(const bf16x8*)(Ks + (32 + r32) * 136 + m * 64 + ks * 16 + hh * 8);
        const bf16x8 k0 = *(const bf16x8*)(Ks + r32 * 136 + m * 64 + ks * 16 + hh * 8);
        S1 = MFMA32(k1, qf[ks], S1);
        S0 = MFMA32(k0, qf[ks], S0);
      }
      float ps = 0.f;
#pragma unroll
      for (int sub = 1; sub >= 0; sub--) {
        uint32_t pw[8];
#pragma unroll
        for (int j = 0; j < 8; j++) {
          const float p0 = __builtin_amdgcn_exp2f(sub ? S1[2 * j] : S0[2 * j]);
          const float p1 = __builtin_amdgcn_exp2f(sub ? S1[2 * j + 1] : S0[2 * j + 1]);
          ps += p0 + p1;
          pw[j] = pack2(p0, p1);
        }
        u32x4 t0, t1; t0.x = pw[0]; t0.y = pw[1]; t0.z = pw[2]; t0.w = pw[3]; t1.x = pw[4]; t1.y = pw[5]; t1.z = pw[6]; t1.w = pw[7];
        const bf16x8 pf0 = __builtin_bit_cast(bf16x8, t0), pf1 = __builtin_bit_cast(bf16x8, t1);
#pragma unroll
        for (int d = 0; d < 4; d++)
#pragma unroll
          for (int sp = 0; sp < 2; sp++) {
            const bf16x8 vfr = *(const bf16x8*)(Vs + (d * 32 + r32) * 72 + sub * 32 + sp * 16 + hh * 8);
            O[d] = MFMA32(vfr, sp ? pf1 : pf0, O[d]);
          }
      }
      lsum += ps;
    } else
#pragma unroll
    for (int sub = 1; sub >= 0; sub--) {
      const int Js = J0 + sub * 32;
      if (!wdone && Js <= qpos0 + 31) {
        const float ref = first ? 0.f : mrow;
        const float base = slope2 * (float)(Js + 4 * hh - qpos) - ref;
        f32x16 S;
#pragma unroll
        for (int reg = 0; reg < 16; reg++) S[reg] = fmaf(slope2, (float)((reg & 3) + 8 * (reg >> 2)), base);
        bf16x8 kf[4];
#pragma unroll
        for (int ks = 0; ks < 4; ks++) kf[ks] = *(const bf16x8*)(Ks + (sub * 32 + r32) * 136 + m * 64 + ks * 16 + hh * 8);
        bf16x8 vf[4][2];
#pragma unroll
        for (int d = 0; d < 4; d++)
#pragma unroll
          for (int sp = 0; sp < 2; sp++) {
            vf[d][sp] = *(const bf16x8*)(Vs + (d * 32 + r32) * 72 + sub * 32 + sp * 16 + hh * 8);
          }
#pragma unroll
        for (int ks = 0; ks < 4; ks++) S = MFMA32(kf[ks], qf[ks], S);
        if (!fast) {
          const bool diag = (Js + 31 > qpos0);
          float mx = -INFINITY;
#pragma unroll
          for (int reg = 0; reg < 16; reg++) {
            const int key = Js + (reg & 3) + 8 * (reg >> 2) + 4 * hh;
            if (diag && key > qpos) S[reg] = -INFINITY;
            mx = fmaxf(mx, S[reg]);
          }
          mx = fmaxf(mx, __shfl_xor(mx, 32));
          const float mrel = first ? mx : fmaxf(mx, 0.f);
          const float alpha = first ? 0.f : __builtin_amdgcn_exp2f(-mrel);
          if (__any(alpha != 1.f)) {
#pragma unroll
            for (int d = 0; d < 4; d++)
#pragma unroll
              for (int r = 0; r < 16; r++) O[d][r] *= alpha;
            lsum *= alpha;
          }
          mrow = ref + mrel;
#pragma unroll
          for (int reg = 0; reg < 16; reg++) S[reg] -= mrel;
          first = false;
          fast = __all(bound2 - mrow <= 100.f);
        }
        float ps = 0.f;
        uint32_t pw[8];
#pragma unroll
        for (int j = 0; j < 8; j++) {
          const float p0 = __builtin_amdgcn_exp2f(S[2 * j]), p1 = __builtin_amdgcn_exp2f(S[2 * j + 1]);
          ps += p0 + p1;
          pw[j] = pack2(p0, p1);
        }
        lsum += ps;
        u32x4 t0, t1; t0.x = pw[0]; t0.y = pw[1]; t0.z = pw[2]; t0.w = pw[3]; t1.x = pw[4]; t1.y = pw[5]; t1.z = pw[6]; t1.w = pw[7];
        const bf16x8 pf0 = __builtin_bit_cast(bf16x8, t0), pf1 = __builtin_bit_cast(bf16x8, t1);
#pragma unroll
        for (int d = 0; d < 4; d++) {
#pragma unroll
          for (int sp = 0; sp < 2; sp++) O[d] = MFMA32(vf[d][sp], sp ? pf1 : pf0, O[d]);
        }
      }
    }
    if (!wdone) wdone = __all((bound2 - slope2 * (float)(qpos - (J0 - 1)) - mrow) < -40.f);
    if (kt > 0) lstore((kt - 1) & 1);
    if (!__syncthreads_or(!wdone)) break;
  }
  __builtin_amdgcn_s_setprio(0);
  int nxt = 0;
  if (tid == 256 && qctr) nxt = atomicAdd(qctr, 1);
  u32x2 zpre[4][4];
  {
    const uint32_t zoff = ((uint32_t)(b * 8192 + qpos) * 1024u + (uint32_t)(h * 128 + 4 * hh)) * 2u;
#pragma unroll
    for (int d = 0; d < 4; d++)
#pragma unroll
      for (int rg = 0; rg < 4; rg++)
        zpre[d][rg] = (m == 0) ? *(const u32x2*)((const char*)p.ws + OFF_ZA + (zoff + (uint32_t)((d * 32 + 8 * rg) * 2))) : u32x2{0u, 0u};
  }
  lsum += __shfl_xor(lsum, 32);
  const float inv = 1.f / lsum;
  if (m == 1) {
    const float sc = inv * lam;
#pragma unroll
    for (int d = 0; d < 4; d++)
#pragma unroll
      for (int reg = 0; reg < 16; reg++)
        ex[(qt * 128 + d * 32 + (reg & 3) + 8 * (reg >> 2) + 4 * hh) * 32 + r32] = O[d][reg] * sc;
  }
  __syncthreads();
  if (m == 0 && !dry) {
    float ssq = 0.f;
#pragma unroll
    for (int d = 0; d < 4; d++)
#pragma unroll
      for (int reg = 0; reg < 16; reg++) {
        const float v = O[d][reg] * inv - ex[(qt * 128 + d * 32 + (reg & 3) + 8 * (reg >> 2) + 4 * hh) * 32 + r32];
        O[d][reg] = v; ssq += v * v;
      }
    ssq += __shfl_xor(ssq, 32);
    const float rs = rsqrtf(ssq * (1.f / 128.f) + EPS) * 0.8f;
    const size_t rowoff = (size_t)(b * 8192 + qpos) * 1024 + h * 128;
    u16* YA = (u16*)(p.ws + OFF_Q);
#pragma unroll
    for (int d = 0; d < 4; d++)
#pragma unroll
      for (int rg = 0; rg < 4; rg++) {
        const int dv0 = d * 32 + 8 * rg + 4 * hh;
        const u32x2 zv = zpre[d][rg];
        const float4 sg = *(const float4*)(p.subln_gain + dv0);
        u32x2 o;
        o.x = pack2(O[d][rg * 4 + 0] * rs * sg.x * silu(bflo(zv.x)), O[d][rg * 4 + 1] * rs * sg.y * silu(bfhi(zv.x)));
        o.y = pack2(O[d][rg * 4 + 2] * rs * sg.z * silu(bflo(zv.y)), O[d][rg * 4 + 3] * rs * sg.w * silu(bfhi(zv.y)));
        *(u32x2*)(YA + rowoff + dv0) = o;
      }
  }
  if (tid == 256 && qctr) *s_next = nxt;
  __syncthreads();
}

__device__ __forceinline__ void phase_final(const Params& p) {
  const int tid = threadIdx.x, lane = tid & 63, wid = tid >> 6;
  for (int row0 = (blockIdx.x * 8 + wid) * 8; row0 < T_; row0 += gridDim.x * 64) {
    float4 v[8][4]; float ss[8];
#pragma unroll
    for (int r = 0; r < 8; r++) {
      const float4* orow = (const float4*)(p.out + (size_t)(row0 + r) * 1024);
#pragma unroll
      for (int i = 0; i < 4; i++) v[r][i] = orow[lane + 64 * i];
    }
#pragma unroll
    for (int r = 0; r < 8; r++) {
      float t = 0.f;
#pragma unroll
      for (int i = 0; i < 4; i++) t += v[r][i].x * v[r][i].x + v[r][i].y * v[r][i].y + v[r][i].z * v[r][i].z + v[r][i].w * v[r][i].w;
      ss[r] = rsqrtf(wave_sum(t) * (1.f / 1024.f) + EPS);
    }
#pragma unroll
    for (int i = 0; i < 4; i++) {
      const float4 g = ((const float4*)p.final_gain)[lane + 64 * i];
#pragma unroll
      for (int r = 0; r < 8; r++) {
        const float rs = ss[r];
        float4 o; o.x = v[r][i].x * rs * g.x; o.y = v[r][i].y * rs * g.y; o.z = v[r][i].z * rs * g.z; o.w = v[r][i].w * rs * g.w;
        ((float4*)(p.out + (size_t)(row0 + r) * 1024))[lane + 64 * i] = o;
      }
    }
  }
}

#ifndef PROBE
#define PROBE 0
#endif
__global__ void __launch_bounds__(512) fwd_megakernel(Params p) {
  cg::grid_group grid = cg::this_grid();
  extern __shared__ __attribute__((aligned(16))) char smem[];
  __shared__ int s_item;
  __shared__ uint4 xb_words;
  if (threadIdx.x == 0) xb_words = make_uint4(0u, 0u, 0u, 0u);
  __syncthreads();
  const XcdBarrier xb = xcd_barrier_post((unsigned*)(p.ws + OFF_BAR), (volatile LAS unsigned*)&xb_words);
#define GSYNC() xcd_barrier(xb)
  if (p.out == nullptr) grid.sync();
  phase_prep(p, smem);
  GSYNC();
  if (threadIdx.x == 0) {
    unsigned* bar = (unsigned*)(p.ws + OFF_BAR);
    unsigned pre = 0u;
    for (unsigned jx = 0; jx < xb.x; ++jx) pre += xb_ld(&bar[XB_XCNT(jx)]);
    const unsigned v = pre + xb_words.z;
    xb_words.w = (gridDim.x == 256) ? ((v & 31u) * 8u + (v >> 5)) : v;
  }
  __syncthreads();
#if PROBE == 2
  phase_prep(p, smem);
  GSYNC();
  if (threadIdx.x == 0) {
    unsigned* bar = (unsigned*)(p.ws + OFF_BAR);
    unsigned pre = 0u;
    for (unsigned jx = 0; jx < xb.x; ++jx) pre += xb_ld(&bar[XB_XCNT(jx)]);
    const unsigned v = pre + xb_words.z;
    xb_words.w = (gridDim.x == 256) ? ((v & 31u) * 8u + (v >> 5)) : v;
  }
  __syncthreads();
#endif
  gemm_phase<0>(p, smem, false, (int)xb_words.w);
  GSYNC();
#if PROBE == 1
  gemm_phase<0>(p, smem, false, (int)xb_words.w);
  GSYNC();
#endif
  phase_states(p, smem);
  GSYNC();
  phase_scan(p);
  GSYNC();
#if PROBE == 3
  phase_states(p, smem);
  GSYNC();
  phase_scan(p);
  GSYNC();
#endif
#if PROBE == 7
  for (int it = blockIdx.x; it < 256; it += gridDim.x) ssd_out_item(p, smem, it, true);
#endif
#if PROBE == 6
  GSYNC(); GSYNC(); GSYNC(); GSYNC(); GSYNC(); GSYNC();
#endif
  for (int it = blockIdx.x; it < 256; it += gridDim.x) ssd_out_item(p, smem, it, false);
  {
    const int lane = threadIdx.x & 63;
    const float s1 = wave_sum(p.lq1[lane] * p.lk1[lane]);
    const float s2 = wave_sum(p.lq2[lane] * p.lk2[lane]);
    const float lam = __expf(s1) - __expf(s2) + 0.2f;
    int* ctr = (int*)(p.ws + OFF_CTR);
#if PROBE == 4
    while (true) {
      if (threadIdx.x == 0) s_item = atomicAdd(ctr + 1, 1);
      __syncthreads();
      const int item = s_item;
      __syncthreads();
      if (item >= 1024) break;
      attn_item(p, smem, item, lam, true, nullptr, nullptr);
    }
#endif
    if (threadIdx.x == 0) s_item = atomicAdd(ctr, 1);
    __syncthreads();
    int item = s_item;
    __syncthreads();
    while (item < 1024) {
      attn_item(p, smem, item, lam, false, ctr, &s_item);
      item = s_item;
    }
  }
  GSYNC();
#if PROBE == 5
  gemm_phase<1>(p, smem, true, (int)xb_words.w);
  GSYNC();
#endif
  gemm_phase<1>(p, smem, false, (int)xb_words.w);
  GSYNC();
  phase_final(p);
}

extern "C" void kernel_launch(void* const* d_in, const int* in_sizes, int n_in, void* d_out, int out_size,
                              void* d_ws, size_t ws_size, hipStream_t stream) {
  static int grid_blocks = 0;
  if (grid_blocks == 0) {
    int dev = 0, cus = 0, per_cu = 0;
    hipGetDevice(&dev);
    hipDeviceGetAttribute(&cus, hipDeviceAttributeMultiprocessorCount, dev);
    if (ws_size < WS_NEED || out_size != T_ * 1024) { fprintf(stderr, "workspace too small: %zu < %zu\n", ws_size, (size_t)WS_NEED); grid_blocks = -1; return; }
    if (hipFuncSetAttribute((const void*)fwd_megakernel, hipFuncAttributeMaxDynamicSharedMemorySize, LDS_BYTES) != hipSuccess) {
      fprintf(stderr, "hipFuncSetAttribute failed\n"); grid_blocks = -1; return;
    }
    hipOccupancyMaxActiveBlocksPerMultiprocessor(&per_cu, (const void*)fwd_megakernel, 512, LDS_BYTES);
    if (per_cu < 1) { fprintf(stderr, "occupancy query says %d blocks/CU\n", per_cu); grid_blocks = -1; return; }
    grid_blocks = cus;
  }
  if (grid_blocks < 0) return;
  Params p{};
  p.x = (const float*)d_in[0]; p.norm_gain = (const float*)d_in[1]; p.w_in = (const float*)d_in[2];
  p.conv_w = (const float*)d_in[3]; p.conv_b = (const float*)d_in[4]; p.dt_bias = (const float*)d_in[5];
  p.a_log = (const float*)d_in[6]; p.d_skip = (const float*)d_in[7]; p.ssd_norm_gain = (const float*)d_in[8];
  p.lq1 = (const float*)d_in[9]; p.lk1 = (const float*)d_in[10]; p.lq2 = (const float*)d_in[11];
  p.lk2 = (const float*)d_in[12]; p.subln_gain = (const float*)d_in[13]; p.w_out = (const float*)d_in[14];
  p.final_gain = (const float*)d_in[15];
  p.out = (float*)d_out; p.ws = (char*)d_ws;
  if (hipMemsetAsync((char*)d_ws + OFF_CTR, 0, 256 + XCD_BAR_WORDS * 4, stream) != hipSuccess) { fprintf(stderr, "memset failed\n"); return; }
  void* args[] = {&p};
  hipError_t e = hipLaunchCooperativeKernel((const void*)fwd_megakernel, dim3(grid_blocks), dim3(512), args, LDS_BYTES, stream);
  if (e != hipSuccess) fprintf(stderr, "cooperative launch failed: %s (grid %d)\n", hipGetErrorString(e), grid_blocks);
}
```

```cpp
#include <hip/hip_runtime.h>
#include <hip/hip_cooperative_groups.h>
#include <cstdio>
#include <cstdint>
#include <cstddef>
#include <type_traits>
namespace cg = cooperative_groups;

typedef unsigned short u16;
typedef short bf16x8 __attribute__((ext_vector_type(8)));
typedef float f32x16 __attribute__((ext_vector_type(16)));
typedef uint32_t u32x4 __attribute__((ext_vector_type(4)));
typedef uint32_t u32x2 __attribute__((ext_vector_type(2)));
#define MFMA32(a, b, c) __builtin_amdgcn_mfma_f32_32x32x16_bf16((a), (b), (c), 0, 0, 0)

struct Params {
  const float* x; const float* norm_gain; const float* w_in; const float* conv_w; const float* conv_b;
  const float* dt_bias; const float* a_log; const float* d_skip; const float* ssd_norm_gain;
  const float* lq1; const float* lk1; const float* lq2; const float* lk2; const float* subln_gain;
  const float* w_out; const float* final_gain;
  float* out; char* ws;
};

constexpr int T_ = 16384;
constexpr float EPS = 1e-5f;
constexpr float LOG2E = 1.4426950408889634f;
constexpr int LDS_BYTES = 150 * 1024;
constexpr int NPAD = 6784;

constexpr size_t OFF_WOUTT = 0;
constexpr size_t OFF_PREV = 4194304;
constexpr size_t OFF_ZS = OFF_PREV + 33554432;
constexpr size_t OFF_XBC = OFF_ZS + 33554432;
constexpr size_t OFF_DT = OFF_XBC + 50331648;
constexpr size_t OFF_Q = OFF_DT + 1048576;
constexpr size_t OFF_K = OFF_Q + 33554432;
constexpr size_t OFF_VT = OFF_K + 33554432;
constexpr size_t OFF_ZA = OFF_VT + 33554432;
constexpr size_t OFF_CD = OFF_ZA + 33554432;
constexpr size_t OFF_ROWSS = OFF_CD + 8192;
constexpr size_t OFF_CTR = OFF_ROWSS + 65536;
constexpr size_t OFF_KMAX = OFF_CTR + 64;
constexpr size_t OFF_BAR = OFF_CTR + 256;
constexpr size_t OFF_RSTD = OFF_BAR + 16384;
constexpr size_t WS_NEED = OFF_RSTD + 131072;
constexpr size_t OOFF_WINT = 0;
constexpr size_t OOFF_U = 16777216;
constexpr size_t OOFF_XTG = 33554432;

typedef __bf16 bf16x2_t __attribute__((ext_vector_type(2)));
typedef float f32x2_t __attribute__((ext_vector_type(2)));
__device__ __forceinline__ uint32_t pack2(float a, float b) {
  f32x2_t v; v.x = a; v.y = b;
  return __builtin_bit_cast(uint32_t, __builtin_convertvector(v, bf16x2_t));
}
__device__ __forceinline__ u16 f2bf(float f) { return (u16)(pack2(f, 0.f) & 0xFFFFu); }
__device__ __forceinline__ float bf2f(uint32_t h) { return __uint_as_float(h << 16); }
__device__ __forceinline__ float bflo(uint32_t w) { return __uint_as_float(w << 16); }
__device__ __forceinline__ float bfhi(uint32_t w) { return __uint_as_float(w & 0xFFFF0000u); }
__device__ __forceinline__ float silu(float v) { return v * __builtin_amdgcn_rcpf(1.f + __expf(-v)); }
__device__ __forceinline__ float wave_sum(float v) {
#pragma unroll
  for (int o = 32; o > 0; o >>= 1) v += __shfl_xor(v, o);
  return v;
}


#define XB_TMO      128
#define XB_XCNT(j)  (256  + 64 * (j))
#define XB_XSUB(j)  (1280 + 64 * (j))
#define XB_XGEN(j)  (2304 + 64 * (j))
#define XB_TOP      3328
#define XB_TOPGEN   3392
#define XCD_BAR_WORDS 3456
#define XB_SPIN_CAP (1u << 18)
#define LAS __attribute__((address_space(3)))
__device__ __forceinline__ unsigned xb_ld(unsigned* p)              { return __hip_atomic_load(p, __ATOMIC_RELAXED, __HIP_MEMORY_SCOPE_AGENT); }
__device__ __forceinline__ unsigned xb_add(unsigned* p, unsigned v) { return __hip_atomic_fetch_add(p, v, __ATOMIC_RELAXED, __HIP_MEMORY_SCOPE_AGENT); }
__device__ __forceinline__ unsigned xb_xcc_id() { return (unsigned)__builtin_amdgcn_s_getreg((3 << 11) | 20) & 0xFu; }
#define XB_SPIN(cond, bar) do { unsigned _sp = 0; while (cond) { __builtin_amdgcn_s_sleep(1); \
    if ((++_sp & 255u) == 0u) { if (xb_ld(&(bar)[XB_TMO])) break; if (_sp > XB_SPIN_CAP) { atomicAdd(&(bar)[XB_TMO], 1u); break; } } } } while (0)
struct XcdBarrier { unsigned* bar; unsigned x; volatile LAS unsigned* st; };
__device__ __forceinline__ XcdBarrier xcd_barrier_post(unsigned* bar, volatile LAS unsigned* st) {
  XcdBarrier b; b.bar = bar; b.x = xb_xcc_id(); b.st = st;
  if (threadIdx.x == 0) st[2] = xb_add(&bar[XB_XCNT(b.x)], 1u);
  return b;
}
__device__ __forceinline__ void xcd_barrier_complete(unsigned* bar, unsigned x, unsigned& nloc, unsigned& nx) {
  const unsigned G = gridDim.x * gridDim.y * gridDim.z;
  unsigned sum, cnt, mine, sp = 0u;
  for (;;) {
    sum = 0u; cnt = 0u; mine = 0u;
#pragma unroll
    for (unsigned j = 0; j < 16; ++j) { const unsigned c = xb_ld(&bar[XB_XCNT(j)]); sum += c; cnt += (c > 0u) ? 1u : 0u; mine = (j == x) ? c : mine; }
    if (sum == G) break;
    __builtin_amdgcn_s_sleep(1);
    if ((++sp & 255u) == 0u) { if (xb_ld(&bar[XB_TMO])) break; if (sp > XB_SPIN_CAP) { atomicAdd(&bar[XB_TMO], 1u); break; } }
  }
  nloc = mine > 0u ? mine : 1u; nx = cnt > 0u ? cnt : 1u;
}
__device__ __forceinline__ void xcd_barrier(const XcdBarrier& b) {
  asm volatile("s_waitcnt vmcnt(0)" ::: "memory");
  __syncthreads();
  if (threadIdx.x == 0) {
    unsigned* bar = b.bar;
    __builtin_amdgcn_s_waitcnt(0);
    unsigned nloc = b.st[0], nx = b.st[1];
    if (nloc == 0u) { xcd_barrier_complete(bar, b.x, nloc, nx); b.st[0] = nloc; b.st[1] = nx; }
    const unsigned old = xb_add(&bar[XB_XSUB(b.x)], 1u);
    const unsigned gen = old / nloc;
    if (old + 1u == (gen + 1u) * nloc) {
      __builtin_amdgcn_fence(__ATOMIC_RELEASE, "agent");
      asm volatile("s_waitcnt vmcnt(0)" ::: "memory");
      const unsigned og = xb_add(&bar[XB_TOP], 1u);
      const unsigned tg = og / nx;
      if (og + 1u == (tg + 1u) * nx) xb_add(&bar[XB_TOPGEN], 1u);
      else XB_SPIN(xb_ld(&bar[XB_TOPGEN]) == tg, bar);
      __builtin_amdgcn_fence(__ATOMIC_ACQUIRE, "agent");
      xb_add(&bar[XB_XGEN(b.x)], 1u);
      asm volatile("s_waitcnt vmcnt(0)" ::: "memory");
    } else {
      XB_SPIN(xb_ld(&bar[XB_XGEN(b.x)]) == gen, bar);
      __builtin_amdgcn_fence(__ATOMIC_ACQUIRE, "agent");
      asm volatile("s_waitcnt vmcnt(0)" ::: "memory");
    }
  }
  __syncthreads();
}

__device__ __forceinline__ void phase_prep(const Params& p, char* smem) {
  const int tid = threadIdx.x, lane = tid & 63, wid = tid >> 6;
  float* tile = (float*)smem;
  u16* WinT = (u16*)((char*)p.out + OOFF_WINT);
  u16* WoutT = (u16*)(p.ws + OFF_WOUTT);
  u16* U = (u16*)((char*)p.out + OOFF_U);
  constexpr int NT_IN = (NPAD / 64) * 16;
  constexpr int NT_OUT = 16 * 32;
  struct TP { const float* src; u16* dst; int src_ld, dst_ld, k0, n0src, n0dst, nvalid; };
  auto tparams = [&](int t) {
    TP q;
    if (t < NT_IN) {
      const int nt = t >> 4, kt = t & 15; q.n0dst = nt * 64; q.k0 = kt * 64;
      if (q.n0dst < 2560) { q.n0src = q.n0dst; q.nvalid = 64; }
      else if (q.n0dst < 6656) { q.n0src = q.n0dst + 16; q.nvalid = 64; }
      else if (q.n0dst == 6656) { q.n0src = 2560; q.nvalid = 16; }
      else { q.n0src = 0; q.nvalid = 0; }
      q.src = p.w_in; q.src_ld = 6672; q.dst = WinT; q.dst_ld = 1024;
    } else {
      const int tt = t - NT_IN, nt = tt >> 5, kt = tt & 31; q.n0dst = nt * 64; q.n0src = q.n0dst; q.nvalid = 64; q.k0 = kt * 64;
      q.src = p.w_out; q.src_ld = 1024; q.dst = WoutT; q.dst_ld = 2048;
    }
    return q;
  };
  float nv[8];
  auto tload = [&](const TP& q) {
#pragma unroll
    for (int i = 0; i < 8; i++) {
      const int r = (tid >> 6) + 8 * i, c = tid & 63;
      nv[i] = (c < q.nvalid) ? q.src[(size_t)(q.k0 + r) * q.src_ld + q.n0src + c] : 0.f;
      if (q.src == p.w_out && q.k0 + r < 1024) nv[i] *= p.ssd_norm_gain[q.k0 + r];
    }
  };
  if (blockIdx.x < NT_IN + NT_OUT) tload(tparams(blockIdx.x));
  for (int t = blockIdx.x; t < NT_IN + NT_OUT; t += gridDim.x) {
    const TP q = tparams(t);
#pragma unroll
    for (int i = 0; i < 8; i++) tile[((tid >> 6) + 8 * i) * 65 + (tid & 63)] = nv[i];
    __syncthreads();
    if (t + (int)gridDim.x < NT_IN + NT_OUT) tload(tparams(t + gridDim.x));
    {
      const int n = tid >> 3, kc = (tid & 7) * 8;
      u32x4 o;
      o.x = pack2(tile[(kc + 0) * 65 + n], tile[(kc + 1) * 65 + n]);
      o.y = pack2(tile[(kc + 2) * 65 + n], tile[(kc + 3) * 65 + n]);
      o.z = pack2(tile[(kc + 4) * 65 + n], tile[(kc + 5) * 65 + n]);
      o.w = pack2(tile[(kc + 6) * 65 + n], tile[(kc + 7) * 65 + n]);
      *(u32x4*)(q.dst + (size_t)(q.n0dst + n) * q.dst_ld + q.k0 + kc) = o;
    }
    __syncthreads();
  }
  for (int row0 = (blockIdx.x * 8 + wid) * 8; row0 < T_; row0 += gridDim.x * 64) {
    float4 v[8][4]; float ss[8];
#pragma unroll
    for (int r = 0; r < 8; r++) {
      const float4* xr = (const float4*)(p.x + (size_t)(row0 + r) * 1024);
#pragma unroll
      for (int i = 0; i < 4; i++) v[r][i] = xr[lane + 64 * i];
    }
#pragma unroll
    for (int r = 0; r < 8; r++) {
      float t = 0.f;
#pragma unroll
      for (int i = 0; i < 4; i++) t += v[r][i].x * v[r][i].x + v[r][i].y * v[r][i].y + v[r][i].z * v[r][i].z + v[r][i].w * v[r][i].w;
      ss[r] = rsqrtf(wave_sum(t) * (1.f / 1024.f) + EPS);
    }
#pragma unroll
    for (int i = 0; i < 4; i++) {
      const float4 g = ((const float4*)p.norm_gain)[lane + 64 * i];
#pragma unroll
      for (int r = 0; r < 8; r++) {
        const float rs = ss[r];
        u32x2 o; o.x = pack2(v[r][i].x * rs * g.x, v[r][i].y * rs * g.y); o.y = pack2(v[r][i].z * rs * g.z, v[r][i].w * rs * g.w);
        *(u32x2*)(U + (size_t)(row0 + r) * 1024 + (lane + 64 * i) * 4) = o;
      }
    }
  }
}

__device__ __forceinline__ float dpp_xor1(float v) {
  return __builtin_bit_cast(float, __builtin_amdgcn_mov_dpp(__builtin_bit_cast(int, v), 0xB1, 0xF, 0xF, true));
}

template <int MODE, int NT, bool SWP>
__device__ __forceinline__ void gemm_tile(const Params& p, char* smem, int m0, int n0) {
  constexpr int KDIM = MODE == 0 ? 1024 : 2048;
  constexpr int KT = KDIM / 64;
  constexpr int LDT = 72;
  constexpr int BROWS = 64 * NT;
  constexpr int WN = 32 * NT;
  u16* As = (u16*)smem;
  u16* Bs = As + 2 * 256 * LDT;
  const int tid = threadIdx.x, lane = tid & 63, w = tid >> 6;
  const int wm = w & 3, wn = w >> 2, r32 = lane & 31, hh = lane >> 5;
  const u16* Wt = MODE == 0 ? (const u16*)((char*)p.out + OOFF_WINT) : (const u16*)(p.ws + OFF_WOUTT);
  const u16* A0 = MODE == 0 ? (const u16*)((char*)p.out + OOFF_U) : (const u16*)(p.ws + OFF_ZS);
  const u16* A1 = (const u16*)(p.ws + OFF_Q);
  const int lrow = tid >> 3, lcc = (tid & 7) * 8;
  f32x16 acc[2][NT];
#pragma unroll
  for (int i = 0; i < 2; i++)
#pragma unroll
    for (int j = 0; j < NT; j++)
#pragma unroll
      for (int r = 0; r < 16; r++) acc[i][j][r] = 0.f;
  u32x4 ra[4], rb[NT];
  const uint32_t aoff0 = (uint32_t)(m0 + lrow) * 2048u + (uint32_t)lcc * 2u;
  const uint32_t boff0 = (uint32_t)(n0 + lrow) * (uint32_t)(KDIM * 2) + (uint32_t)lcc * 2u;
  auto gload = [&](int kt) {
    const char* abase = (const char*)((MODE == 0 || kt < 16) ? A0 : A1);
    const uint32_t ao = aoff0 + (uint32_t)(kt & 15) * 128u;
    const uint32_t bo = boff0 + (uint32_t)kt * 128u;
#pragma unroll
    for (int i = 0; i < 4; i++) ra[i] = *(const u32x4*)(abase + (ao + (uint32_t)i * (64u * 2048u)));
#pragma unroll
    for (int i = 0; i < NT; i++) rb[i] = *(const u32x4*)((const char*)Wt + (bo + (uint32_t)i * (uint32_t)(64 * KDIM * 2)));
  };
  auto lstore = [&](int buf) {
#pragma unroll
    for (int i = 0; i < 4; i++) *(u32x4*)(As + buf * 256 * LDT + (lrow + 64 * i) * LDT + lcc) = ra[i];
#pragma unroll
    for (int i = 0; i < NT; i++) *(u32x4*)(Bs + buf * 256 * LDT + (lrow + 64 * i) * LDT + lcc) = rb[i];
  };
  float rs0[2] = {1.f, 1.f}, rs1[2] = {1.f, 1.f};
  if (MODE == 1 && SWP) {
    const float* RS = (const float*)(p.ws + OFF_RSTD);
#pragma unroll
    for (int i = 0; i < 2; i++) { const float2 r = *(const float2*)(RS + (m0 + wm * 64 + i * 32 + r32) * 2); rs0[i] = r.x * __builtin_amdgcn_rcpf(r.y); rs1[i] = r.y; }
  }
  gload(0); lstore(0);
  __syncthreads();
  for (int kt = 0; kt < KT; kt++) {
    const int buf = kt & 1;
    const u16* a_base = As + buf * 256 * LDT + (wm * 64 + r32) * LDT + hh * 8;
    const u16* b_base = Bs + buf * 256 * LDT + (wn * WN + r32) * LDT + hh * 8;
    bf16x8 afb[2][2], bfb[2][NT];
#pragma unroll
    for (int i = 0; i < 2; i++) afb[0][i] = *(const bf16x8*)(a_base + i * 32 * LDT);
#pragma unroll
    for (int j = 0; j < NT; j++) bfb[0][j] = *(const bf16x8*)(b_base + j * 32 * LDT);
    __builtin_amdgcn_sched_barrier(0);
    if (kt + 1 < KT) gload(kt + 1);
#pragma unroll
    for (int ks = 0; ks < 4; ks++) {
      if (ks < 3) {
#pragma unroll
        for (int i = 0; i < 2; i++) afb[(ks + 1) & 1][i] = *(const bf16x8*)(a_base + i * 32 * LDT + (ks + 1) * 16);
#pragma unroll
        for (int j = 0; j < NT; j++) bfb[(ks + 1) & 1][j] = *(const bf16x8*)(b_base + j * 32 * LDT + (ks + 1) * 16);
      }
      const bf16x8 (&af)[2] = afb[ks & 1];
      const bf16x8 (&bfr)[NT] = bfb[ks & 1];
#pragma unroll
      for (int i = 0; i < 2; i++)
#pragma unroll
        for (int j = 0; j < NT; j++) acc[i][j] = SWP ? MFMA32(bfr[j], af[i], acc[i][j]) : MFMA32(af[i], bfr[j], acc[i][j]);
      __builtin_amdgcn_sched_barrier(0);
      if (kt + 1 < KT) {
        u16* an = As + (buf ^ 1) * 256 * LDT + lrow * LDT + lcc;
        u16* bn = Bs + (buf ^ 1) * 256 * LDT + lrow * LDT + lcc;
        if (ks == 1) { *(u32x4*)(an) = ra[0]; *(u32x4*)(an + 64 * LDT) = ra[1]; *(u32x4*)(an + 128 * LDT) = ra[2]; }
        if (ks == 2) { *(u32x4*)(an + 192 * LDT) = ra[3]; *(u32x4*)(bn) = rb[0]; *(u32x4*)(bn + 64 * LDT) = rb[1]; }
        if (ks == 3 && NT == 4) { *(u32x4*)(bn + 128 * LDT) = rb[NT - 2]; *(u32x4*)(bn + 192 * LDT) = rb[NT - 1]; }
      }
    }
    if (MODE == 1 && SWP && (kt == 7 || kt == 15)) {
#pragma unroll
      for (int i = 0; i < 2; i++) {
        const float sc = (kt == 7) ? rs0[i] : rs1[i];
#pragma unroll
        for (int j = 0; j < NT; j++)
#pragma unroll
          for (int r = 0; r < 16; r++) acc[i][j][r] *= sc;
      }
    }
    __syncthreads();
  }
  if (SWP) {
    const int row0 = m0 + wm * 64 + r32;
    if (MODE == 0) {
      if (n0 == 6656) {
        if (wn == 0) {
          float* DT = (float*)(p.ws + OFF_DT);
#pragma unroll
          for (int mt = 0; mt < 2; mt++)
#pragma unroll
            for (int g = 0; g < 2; g++) {
              const int c0 = 8 * g + 4 * hh;
              const float4 bias = *(const float4*)(p.dt_bias + c0);
              float4 o;
              { const float v = acc[mt][0][4 * g + 0] + bias.x; o.x = fmaxf(v, 0.f) + log1pf(__expf(-fabsf(v))); }
              { const float v = acc[mt][0][4 * g + 1] + bias.y; o.y = fmaxf(v, 0.f) + log1pf(__expf(-fabsf(v))); }
              { const float v = acc[mt][0][4 * g + 2] + bias.z; o.z = fmaxf(v, 0.f) + log1pf(__expf(-fabsf(v))); }
              { const float v = acc[mt][0][4 * g + 3] + bias.w; o.w = fmaxf(v, 0.f) + log1pf(__expf(-fabsf(v))); }
              *(float4*)(DT + (row0 + mt * 32) * 16 + c0) = o;
            }
        }
      } else if (n0 >= 4608 && n0 < 5632) {
        u16* VT = (u16*)(p.ws + OFF_VT);
        const int q4 = lane & 3;
        const bool q1 = q4 & 1, q2 = q4 & 2;
#pragma unroll
        for (int mt = 0; mt < 2; mt++) {
          const int t0 = (row0 + mt * 32) & ~3;
          const uint32_t tb = ((uint32_t)((t0 >> 13) * 1024 + (n0 - 4608 + wn * WN + 4 * hh + q4)) * 8192u + (uint32_t)(t0 & 8191)) * 2u;
#pragma unroll
          for (int nt = 0; nt < NT; nt++)
#pragma unroll
            for (int g = 0; g < 4; g++) {
              const float a0 = acc[mt][nt][4 * g + 0], a1 = acc[mt][nt][4 * g + 1], a2 = acc[mt][nt][4 * g + 2], a3 = acc[mt][nt][4 * g + 3];
              const float r1 = dpp_xor1(q1 ? a0 : a1), r3 = dpp_xor1(q1 ? a2 : a3);
              const uint32_t p01 = q1 ? pack2(r1, a1) : pack2(a0, r1);
              const uint32_t p23 = q1 ? pack2(r3, a3) : pack2(a2, r3);
              const uint32_t rx = (uint32_t)__builtin_amdgcn_mov_dpp((int)(q2 ? p01 : p23), 0x4E, 0xF, 0xF, true);
              u32x2 o; o.x = q2 ? rx : p01; o.y = q2 ? p23 : rx;
              *(u32x2*)((char*)VT + (tb + (uint32_t)(nt * 32 + 8 * g) * 16384u)) = o;
            }
        }
      } else {
        u16* dst; int ld, coff; float scale = 1.f;
        if (n0 < 1024) { dst = (u16*)(p.ws + OFF_ZS); ld = 1024; coff = 0; }
        else if (n0 < 2560) { dst = (u16*)(p.ws + OFF_XBC); ld = 1536; coff = 1024; }
        else if (n0 < 3584) { dst = (u16*)(p.ws + OFF_Q); ld = 1024; coff = 2560; scale = 0.125f * LOG2E; }
        else if (n0 < 4608) { dst = (u16*)(p.ws + OFF_K); ld = 1024; coff = 3584; }
        else { dst = (u16*)(p.ws + OFF_ZA); ld = 1024; coff = 5632; }
#pragma unroll
        for (int mt = 0; mt < 2; mt++) {
          const uint32_t rowb = ((uint32_t)(row0 + mt * 32) * (uint32_t)ld + (uint32_t)(n0 + wn * WN - coff + (hh ? 8 : 0))) * 2u;
#pragma unroll
          for (int nt = 0; nt < NT; nt++)
#pragma unroll
            for (int k = 0; k < 4; k += 2) {
              uint32_t ax = pack2(acc[mt][nt][4 * k + 0] * scale, acc[mt][nt][4 * k + 1] * scale);
              uint32_t ay = pack2(acc[mt][nt][4 * k + 2] * scale, acc[mt][nt][4 * k + 3] * scale);
              uint32_t bx = pack2(acc[mt][nt][4 * k + 4] * scale, acc[mt][nt][4 * k + 5] * scale);
              uint32_t by = pack2(acc[mt][nt][4 * k + 6] * scale, acc[mt][nt][4 * k + 7] * scale);
              { auto r = __builtin_amdgcn_permlane32_swap(ax, bx, false, false); ax = r[0]; bx = r[1]; }
              { auto r = __builtin_amdgcn_permlane32_swap(ay, by, false, false); ay = r[0]; by = r[1]; }
              u32x4 o; o.x = ax; o.y = ay; o.z = bx; o.w = by;
              *(u32x4*)((char*)dst + (rowb + (uint32_t)((nt * 32 + 8 * k) * 2))) = o;
            }
        }
        if (n0 >= 3584 && n0 < 4608) {
#pragma unroll
          for (int grp = 0; grp < NT / 2; grp++) {
            float mx = 0.f;
#pragma unroll
            for (int mt = 0; mt < 2; mt++) {
              float v = 0.f;
#pragma unroll
              for (int reg = 0; reg < 16; reg++) v += acc[mt][2 * grp][reg] * acc[mt][2 * grp][reg] + acc[mt][2 * grp + 1][reg] * acc[mt][2 * grp + 1][reg];
              v += __shfl_xor(v, 32);
              mx = fmaxf(mx, v);
            }
#pragma unroll
            for (int o = 1; o < 32; o <<= 1) mx = fmaxf(mx, __shfl_xor(mx, o));
            if (lane == 0) atomicMax((unsigned int*)(p.ws + OFF_KMAX) + (m0 >> 13) * 16 + ((n0 - 3584 + wn * WN + grp * 64) >> 6), __float_as_uint(mx));
          }
        }
      }
    } else {
#pragma unroll
      for (int mt = 0; mt < 2; mt++) {
        const uint32_t rowb = ((uint32_t)(row0 + mt * 32) * 1024u + (uint32_t)(n0 + wn * WN + 4 * hh)) * 4u;
#pragma unroll
        for (int nt = 0; nt < NT; nt++)
#pragma unroll
          for (int g = 0; g < 4; g++) {
            const uint32_t idx = rowb + (uint32_t)((nt * 32 + 8 * g) * 4);
            const float4 xv = *(const float4*)((const char*)p.x + idx);
            float4 o;
            o.x = xv.x + acc[mt][nt][4 * g + 0]; o.y = xv.y + acc[mt][nt][4 * g + 1];
            o.z = xv.z + acc[mt][nt][4 * g + 2]; o.w = xv.w + acc[mt][nt][4 * g + 3];
            *(float4*)((char*)p.out + idx) = o;
          }
      }
    }
    return;
  }
  const int rbase = m0 + wm * 64 + 4 * hh;
  const int cbase = n0 + wn * WN + r32;
  const bool odd = lane & 1;
  if (MODE == 0) {
    if (n0 >= 4608 && n0 < 5632) {
      u16* VT = (u16*)(p.ws + OFF_VT);
#pragma unroll
      for (int mt = 0; mt < 2; mt++)
#pragma unroll
        for (int nt = 0; nt < NT; nt++)
#pragma unroll
          for (int rg = 0; rg < 4; rg++) {
            const int row0 = rbase + mt * 32 + 8 * rg;
            const int c = cbase + nt * 32 - 4608;
            const int bb = row0 >> 13, sq = row0 & 8191;
            u32x2 o; o.x = pack2(acc[mt][nt][rg * 4 + 0], acc[mt][nt][rg * 4 + 1]); o.y = pack2(acc[mt][nt][rg * 4 + 2], acc[mt][nt][rg * 4 + 3]);
            *(u32x2*)((char*)VT + ((uint32_t)(bb * 1024 + c) * 8192u + (uint32_t)sq) * 2u) = o;
          }
    } else if (NT == 2 && n0 == 6656) {
      if (wn == 0 && r32 < 16) {
        float* DT = (float*)(p.ws + OFF_DT);
        const float bias = p.dt_bias[r32];
#pragma unroll
        for (int mt = 0; mt < 2; mt++)
#pragma unroll
          for (int reg = 0; reg < 16; reg++) {
            const int row = rbase + mt * 32 + (reg & 3) + 8 * (reg >> 2);
            const float v = acc[mt][0][reg] + bias;
            DT[row * 16 + r32] = fmaxf(v, 0.f) + log1pf(__expf(-fabsf(v)));
          }
      }
    } else {
      u16* dst; int ld, coff; float scale = 1.f;
      if (n0 < 1024) { dst = (u16*)(p.ws + OFF_ZS); ld = 1024; coff = 0; }
      else if (n0 < 2560) { dst = (u16*)(p.ws + OFF_XBC); ld = 1536; coff = 1024; }
      else if (n0 < 3584) { dst = (u16*)(p.ws + OFF_Q); ld = 1024; coff = 2560; scale = 0.125f * LOG2E; }
      else if (n0 < 4608) { dst = (u16*)(p.ws + OFF_K); ld = 1024; coff = 3584; }
      else { dst = (u16*)(p.ws + OFF_ZA); ld = 1024; coff = 5632; }
#pragma unroll
      for (int mt = 0; mt < 2; mt++)
#pragma unroll
        for (int nt = 0; nt < NT; nt++)
#pragma unroll
          for (int t = 0; t < 8; t++) {
            const float va = acc[mt][nt][2 * t] * scale, vb = acc[mt][nt][2 * t + 1] * scale;
            const float recv = dpp_xor1(odd ? va : vb);
            const int reg = 2 * t + (odd ? 1 : 0);
            const int row = rbase + mt * 32 + (reg & 3) + 8 * (reg >> 2);
            const int col = ((cbase + nt * 32) & ~1) - coff;
            *(uint32_t*)((char*)dst + ((uint32_t)row * (uint32_t)ld + (uint32_t)col) * 2u) = odd ? pack2(recv, vb) : pack2(va, recv);
          }
      if (n0 >= 3584 && n0 < 4608) {
#pragma unroll
        for (int grp = 0; grp < NT / 2; grp++) {
          float mx = 0.f;
#pragma unroll
          for (int mt = 0; mt < 2; mt++)
#pragma unroll
            for (int reg = 0; reg < 16; reg++) {
              float v = acc[mt][2 * grp][reg] * acc[mt][2 * grp][reg] + acc[mt][2 * grp + 1][reg] * acc[mt][2 * grp + 1][reg];
#pragma unroll
              for (int o = 1; o < 32; o <<= 1) v += __shfl_xor(v, o);
              mx = fmaxf(mx, v);
            }
          mx = fmaxf(mx, __shfl_xor(mx, 32));
          if (lane == 0) atomicMax((unsigned int*)(p.ws + OFF_KMAX) + (m0 >> 13) * 16 + ((n0 - 3584 + wn * WN + grp * 64) >> 6), __float_as_uint(mx));
        }
      }
    }
  } else {
#pragma unroll
    for (int mt = 0; mt < 2; mt++)
#pragma unroll
      for (int nt = 0; nt < NT; nt++)
#pragma unroll
        for (int t = 0; t < 8; t++) {
          const float va = acc[mt][nt][2 * t], vb = acc[mt][nt][2 * t + 1];
          const float recv = dpp_xor1(odd ? va : vb);
          const int reg = 2 * t + (odd ? 1 : 0);
          const int row = rbase + mt * 32 + (reg & 3) + 8 * (reg >> 2);
          const int col = (cbase + nt * 32) & ~1;
          const uint32_t idx = ((uint32_t)row * 1024u + (uint32_t)col) * 4u;
          const float2 xv = *(const float2*)((const char*)p.x + idx);
          float2 o;
          o.x = xv.x + (odd ? recv : va); o.y = xv.y + (odd ? vb : recv);
          *(float2*)((char*)p.out + idx) = o;
        }
  }
}

__device__ __forceinline__ void dt_piece(const Params& p, char* smem, int m0) {
  const int tid = threadIdx.x, lane = tid & 63, w = tid >> 6, r32 = lane & 31, hh = lane >> 5;
  const u16* U = (const u16*)((const char*)p.out + OOFF_U);
  const u16* Wd = (const u16*)((const char*)p.out + OOFF_WINT) + (size_t)6656 * 1024;
  float* red = (float*)smem;
  f32x16 acc[2];
#pragma unroll
  for (int i = 0; i < 2; i++)
#pragma unroll
    for (int r = 0; r < 16; r++) acc[i][r] = 0.f;
  bf16x8 af[2][8], bfr[8];
  const int kb = w * 128 + hh * 8;
#pragma unroll
  for (int ks = 0; ks < 8; ks++) {
    bfr[ks] = *(const bf16x8*)(Wd + (size_t)r32 * 1024 + kb + ks * 16);
#pragma unroll
    for (int i = 0; i < 2; i++) af[i][ks] = *(const bf16x8*)(U + (size_t)(m0 + i * 32 + r32) * 1024 + kb + ks * 16);
  }
#pragma unroll
  for (int ks = 0; ks < 8; ks++)
#pragma unroll
    for (int i = 0; i < 2; i++) acc[i] = MFMA32(af[i][ks], bfr[ks], acc[i]);
  __syncthreads();
#pragma unroll
  for (int i = 0; i < 2; i++)
#pragma unroll
    for (int reg = 0; reg < 16; reg++)
      red[(w * 64 + i * 32 + (reg & 3) + 8 * (reg >> 2) + 4 * hh) * 32 + r32] = acc[i][reg];
  __syncthreads();
  float* DT = (float*)(p.ws + OFF_DT);
#pragma unroll
  for (int o = tid; o < 1024; o += 512) {
    const int row = o >> 4, col = o & 15;
    float v = p.dt_bias[col];
#pragma unroll
    for (int ww = 0; ww < 8; ww++) v += red[(ww * 64 + row) * 32 + col];
    DT[(m0 + row) * 16 + col] = fmaxf(v, 0.f) + log1pf(__expf(-fabsf(v)));
  }
  __syncthreads();
}

template <int MODE>
__device__ __forceinline__ void gemm_phase(const Params& p, char* smem, bool dry, int vbid) {
  (void)dry;
  const int bid = vbid;
  if (gridDim.x == 256) {
    const int x = bid & 7, j = bid >> 3;
    const int m0 = (x * 8 + (j & 7)) * 256, nq = j >> 3;
    if (MODE == 0) {
#pragma unroll 1
      for (int r = 0; r < 6; r++) {
        const int n0 = (r * 4 + nq) * 256;
        gemm_tile<0, 4, false>(p, smem, m0, n0);
      }
      gemm_tile<0, 2, false>(p, smem, m0, 6144 + nq * 128);
      dt_piece(p, smem, (int)blockIdx.x * 64);
    } else {
      gemm_tile<1, 4, true>(p, smem, m0, nq * 256);
    }
  } else {
    constexpr int NTN = MODE == 0 ? 53 : 8;
    for (int tile = bid; tile < 64 * NTN; tile += gridDim.x) {
      const int n0 = (tile >> 6) * 128;
      gemm_tile<MODE, 2, MODE == 1>(p, smem, (tile & 63) * 256, n0);
    }
  }
}

template <typename F>
__device__ __forceinline__ void conv_run32(const u16* xbc0, int col, bool first_chunk, int l0, const float* cw, const float* cb, F f) {
  const float w0 = cw[col], w1 = cw[1536 + col], w2 = cw[2 * 1536 + col], w3 = cw[3 * 1536 + col], bias = cb[col];
  float u[35];
#pragma unroll
  for (int i = 0; i < 35; i++) {
    const int l = l0 - 3 + i;
    u[i] = (first_chunk && l < 0) ? 0.f : bf2f((uint32_t)xbc0[(ptrdiff_t)l * 1536 + col]);
  }
#pragma unroll
  for (int i = 0; i < 32; i++) {
    const float v = w0 * u[i] + w1 * u[i + 1] + w2 * u[i + 2] + w3 * u[i + 3] + bias;
    f(i, silu(v));
  }
}

__device__ __forceinline__ void phase_states(const Params& p, char* smem) {
  u16* BT = (u16*)smem;
  u16* XT = BT + 128 * 136;
  float* wl = (float*)(XT + 2 * 64 * 136);
  const int tid = threadIdx.x, lane = tid & 63, w = tid >> 6, r32 = lane & 31, hh = lane >> 5;
  const int hg = w >> 2, wq = w & 3;
  const u16* XBC = (const u16*)(p.ws + OFF_XBC);
  const float* DT = (const float*)(p.ws + OFF_DT);
  float* CD = (float*)(p.ws + OFF_CD);
  u16* ST = (u16*)p.out;
  for (int item = blockIdx.x; item < 256; item += gridDim.x) {
    const int g = item & 1, bc = item >> 1, c = bc & 63, b = bc >> 6;
    const int tok0 = b * 8192 + c * 128;
    const u16* xbc0 = XBC + (size_t)tok0 * 1536;
    {
      const int h = g * 8 + w;
      const float v0 = DT[(tok0 + 2 * lane) * 16 + h], v1 = DT[(tok0 + 2 * lane + 1) * 16 + h];
      float sc = v0 + v1;
#pragma unroll
      for (int d = 1; d < 64; d <<= 1) { float t = __shfl_up(sc, d); if (lane >= d) sc += t; }
      const float A = -__expf(p.a_log[h]);
      const float tot = __shfl(sc, 63);
      const float e = sc - (v0 + v1);
      wl[w * 128 + 2 * lane] = v0 * __expf(A * (tot - (e + v0)));
      wl[w * 128 + 2 * lane + 1] = v1 * __expf(A * (tot - sc));
      if (lane == 0) CD[bc * 16 + h] = __expf(A * tot);
    }
    {
      const int ch = tid & 127, q = tid >> 7;
      u16* dst = BT + ch * 136 + q * 32;
      uint32_t pk[16];
      conv_run32(xbc0, 1024 + g * 128 + ch, c == 0, q * 32, p.conv_w, p.conv_b, [&](int i, float v) {
        const uint32_t hb = f2bf(v);
        if (i & 1) pk[i >> 1] |= hb << 16; else pk[i >> 1] = hb;
      });
#pragma unroll
      for (int j = 0; j < 4; j++) { u32x4 o; o.x = pk[4 * j]; o.y = pk[4 * j + 1]; o.z = pk[4 * j + 2]; o.w = pk[4 * j + 3]; *(u32x4*)(dst + 8 * j) = o; }
    }
    for (int hi = 0; hi < 4; hi++) {
      const int hl = hg * 4 + hi, h = g * 8 + hl;
      __syncthreads();
      {
        const int t = tid & 255, ch = t & 63, q = t >> 6;
        u16* dst = XT + hg * 64 * 136 + ch * 136 + q * 32;
        const float* wlh = wl + hl * 128 + q * 32;
        uint32_t pk[16], pg[16];
        float pv = 0.f, ps = 0.f;
        conv_run32(xbc0, h * 64 + ch, c == 0, q * 32, p.conv_w, p.conv_b, [&](int i, float v) {
          const float sc = v * wlh[i];
          if (i & 1) { pk[i >> 1] = pack2(ps, sc); pg[i >> 1] = pack2(pv, v); } else { pv = v; ps = sc; }
        });
        u16* dstg = (u16*)((char*)p.out + OOFF_XTG) + ((size_t)(bc * 16 + h) * 64 + ch) * 128 + q * 32;
#pragma unroll
        for (int j = 0; j < 4; j++) {
          u32x4 o; o.x = pk[4 * j]; o.y = pk[4 * j + 1]; o.z = pk[4 * j + 2]; o.w = pk[4 * j + 3]; *(u32x4*)(dst + 8 * j) = o;
          u32x4 og; og.x = pg[4 * j]; og.y = pg[4 * j + 1]; og.z = pg[4 * j + 2]; og.w = pg[4 * j + 3]; *(u32x4*)(dstg + 8 * j) = og;
        }
      }
      __syncthreads();
      {
        const u16* xt = XT + hg * 64 * 136;
        f32x16 acc[2];
#pragma unroll
        for (int mt = 0; mt < 2; mt++)
#pragma unroll
          for (int r = 0; r < 16; r++) acc[mt][r] = 0.f;
#pragma unroll
        for (int ks = 0; ks < 8; ks++) {
          const bf16x8 bb = *(const bf16x8*)(BT + (wq * 32 + r32) * 136 + ks * 16 + hh * 8);
#pragma unroll
          for (int mt = 0; mt < 2; mt++) {
            const bf16x8 a = *(const bf16x8*)(xt + (mt * 32 + r32) * 136 + ks * 16 + hh * 8);
            acc[mt] = MFMA32(a, bb, acc[mt]);
          }
        }
        u16* dst = ST + ((size_t)(bc * 16 + h) * 64) * 128;
#pragma unroll
        for (int mt = 0; mt < 2; mt++)
#pragma unroll
          for (int reg = 0; reg < 16; reg++) {
            const int pp = mt * 32 + (reg & 3) + 8 * (reg >> 2) + 4 * hh;
            dst[pp * 128 + wq * 32 + r32] = f2bf(acc[mt][reg]);
          }
      }
    }
    __syncthreads();
  }
}

__device__ __forceinline__ void phase_scan(const Params& p) {
  const u16* ST = (const u16*)p.out;
  const float* CD = (const float*)(p.ws + OFF_CD);
  u16* PREV = (u16*)(p.ws + OFF_PREV);
  for (int idx = blockIdx.x * 512 + threadIdx.x; idx < 131072; idx += gridDim.x * 512) {
    const int e = idx * 2;
    const int b = e >> 17, rem = e & 131071, h = rem >> 13;
    float hx = 0.f, hy = 0.f;
#pragma unroll 32
    for (int c = 0; c < 64; c++) {
      const size_t off = (size_t)(b * 64 + c) * 131072 + rem;
      const uint32_t sw = *(const uint32_t*)(ST + off);
      float2 s; s.x = bflo(sw); s.y = bfhi(sw);
      const float d = CD[(b * 64 + c) * 16 + h];
      *(uint32_t*)(PREV + off) = pack2(hx, hy);
      hx = hx * d + s.x; hy = hy * d + s.y;
    }
  }
}

__device__ __forceinline__ void ssd_out_item(const Params& p, char* smem, int item, bool dry) {
  const int g = item & 1, bc = item >> 1, c = bc & 63, b = bc >> 6;
  const int tok0 = b * 8192 + c * 128;
  u16* R1 = (u16*)smem;
  u16* R2 = R1 + 128 * 136;
  u16* XT = R2 + 128 * 136;
  float* dts = (float*)(XT + 2 * 64 * 136);
  float* acs = dts + 1024;
  float* part = acs + 1024;
  float* rstd = part + 256;
  u16* PVB = (u16*)(rstd + 128);
  const int tid = threadIdx.x, lane = tid & 63, w = tid >> 6, r32 = lane & 31, hh = lane >> 5;
  const int lt = w & 3, hg = w >> 2;
  const u16* xbc0 = (const u16*)(p.ws + OFF_XBC) + (size_t)tok0 * 1536;
  const float* DT = (const float*)(p.ws + OFF_DT);
  u16* ZS = (u16*)(p.ws + OFF_ZS);
  const u16* PREV = (const u16*)(p.ws + OFF_PREV);
  const bool first = (c == 0);
  {
    const int h = g * 8 + w;
    const float v0 = DT[(tok0 + 2 * lane) * 16 + h], v1 = DT[(tok0 + 2 * lane + 1) * 16 + h];
    float sc = v0 + v1;
#pragma unroll
    for (int d = 1; d < 64; d <<= 1) { float t = __shfl_up(sc, d); if (lane >= d) sc += t; }
    const float A = -__expf(p.a_log[h]);
    const float e = sc - (v0 + v1);
    dts[w * 128 + 2 * lane] = v0; dts[w * 128 + 2 * lane + 1] = v1;
    acs[w * 128 + 2 * lane] = A * (e + v0); acs[w * 128 + 2 * lane + 1] = A * sc;
  }
  {
    const int ch = tid & 127, q = tid >> 7;
    conv_run32(xbc0, 1280 + g * 128 + ch, first, q * 32, p.conv_w, p.conv_b, [&](int i, float v) { R1[(q * 32 + i) * 136 + ch] = f2bf(v); });
    conv_run32(xbc0, 1024 + g * 128 + ch, first, q * 32, p.conv_w, p.conv_b, [&](int i, float v) { R2[(q * 32 + i) * 136 + ch] = f2bf(v); });
  }
  __syncthreads();
  const u16* cfp = R1 + (lt * 32 + r32) * 136 + hh * 8;
  float ss[16];
#pragma unroll
  for (int r = 0; r < 16; r++) ss[r] = 0.f;
  u32x4 xr[4];
  {
    const char* src = (const char*)p.out + OOFF_XTG + (size_t)(bc * 16 + g * 8 + hg * 4) * 16384;
#pragma unroll
    for (int i = 0; i < 4; i++) xr[i] = *(const u32x4*)(src + ((tid & 255) + 256 * i) * 16);
  }
  for (int hi = 0; hi < 4; hi++) {
    const int h = g * 8 + hg * 4 + hi;
    __syncthreads();
    {
      const int t = tid & 255;
      u16* dstb = XT + hg * 64 * 136;
#pragma unroll
      for (int i = 0; i < 4; i++) {
        const int id = t + 256 * i, row = id >> 4, cc = id & 15;
        *(u32x4*)(dstb + row * 136 + cc * 8) = xr[i];
        *(u32x4*)(PVB + hg * 64 * 136 + row * 136 + cc * 8) = *(const u32x4*)((const char*)PREV + (size_t)(bc * 16 + h) * 16384 + id * 16);
      }
    }
    __syncthreads();
    if (hi < 3) {
      const char* src = (const char*)p.out + OOFF_XTG + (size_t)(bc * 16 + h + 1) * 16384;
#pragma unroll
      for (int i = 0; i < 4; i++) xr[i] = *(const u32x4*)(src + ((tid & 255) + 256 * i) * 16);
    }
    const float* acs_h = acs + (hg * 4 + hi) * 128;
    const float* dts_h = dts + (hg * 4 + hi) * 128;
    const u16* xt = XT + hg * 64 * 136;
    f32x16 acc[2];
#pragma unroll
    for (int pt = 0; pt < 2; pt++)
#pragma unroll
      for (int r = 0; r < 16; r++) acc[pt][r] = 0.f;
    const uint32_t zoff0 = ((uint32_t)(tok0 + lt * 32 + 4 * hh) * 1024u + (uint32_t)(h * 64 + r32)) * 2u;
    u16 zraw[2][16];
#pragma unroll
    for (int reg = 0; reg < 16; reg++)
      zraw[0][reg] = *(const u16*)((const char*)ZS + (zoff0 + (uint32_t)(((reg & 3) + 8 * (reg >> 2)) * 2048)));
    const u16* prev_h = PVB + hg * 64 * 136;
#pragma unroll
    for (int ks = 0; ks < 8; ks++)
#pragma unroll
      for (int pt = 0; pt < 2; pt++) {
        bf16x8 bfr = *(const bf16x8*)(prev_h + (pt * 32 + r32) * 136 + ks * 16 + hh * 8);
        acc[pt] = MFMA32(*(const bf16x8*)(cfp + ks * 16), bfr, acc[pt]);
      }
#pragma unroll
    for (int reg = 0; reg < 16; reg++) {
      const float e = __expf(acs_h[lt * 32 + (reg & 3) + 8 * (reg >> 2) + 4 * hh]);
      acc[0][reg] *= e; acc[1][reg] *= e;
    }
    const int lcol = lt * 32 + r32;
    const float acs_l = acs_h[lcol];
#pragma unroll 1
    for (int st = 0; st <= lt; st++) {
      {
        f32x16 Xs;
#pragma unroll
        for (int r = 0; r < 16; r++) Xs[r] = 0.f;
#pragma unroll
        for (int ks = 0; ks < 8; ks++) {
          bf16x8 a = *(const bf16x8*)(R2 + (st * 32 + r32) * 136 + ks * 16 + hh * 8);
          Xs = MFMA32(a, *(const bf16x8*)(cfp + ks * 16), Xs);
        }
#pragma unroll
        for (int sp = 0; sp < 2; sp++) {
          __builtin_amdgcn_sched_barrier(0);
          float gv[8];
#pragma unroll
          for (int j = 0; j < 8; j++) {
            const int reg = 8 * sp + j;
            const int s = st * 32 + (reg & 3) + 8 * (reg >> 2) + 4 * hh;
            const float v = Xs[reg] * __expf(acs_l - acs_h[s]) * dts_h[s];
            gv[j] = (s <= lcol) ? v : 0.f;
          }
          u32x4 aw; aw.x = pack2(gv[0], gv[1]); aw.y = pack2(gv[2], gv[3]); aw.z = pack2(gv[4], gv[5]); aw.w = pack2(gv[6], gv[7]);
          const bf16x8 af = __builtin_bit_cast(bf16x8, aw);
#pragma unroll
          for (int pt = 0; pt < 2; pt++) {
            const u16* xp = xt + (pt * 32 + r32) * 136 + st * 32 + sp * 16 + hh * 4;
            const u32x2 lo = *(const u32x2*)xp, hi2 = *(const u32x2*)(xp + 8);
            u32x4 bw; bw.x = lo.x; bw.y = lo.y; bw.z = hi2.x; bw.w = hi2.y;
            acc[pt] = MFMA32(af, __builtin_bit_cast(bf16x8, bw), acc[pt]);
          }
        }
      }
    }
    const float dsk = p.d_skip[h];
#pragma unroll
    for (int reg = 0; reg < 16; reg++)
      zraw[1][reg] = *(const u16*)((const char*)ZS + (zoff0 + (uint32_t)(((reg & 3) + 8 * (reg >> 2)) * 2048 + 64)));
#pragma unroll
    for (int pt = 0; pt < 2; pt++)
#pragma unroll
      for (int rg = 0; rg < 4; rg++) {
        __builtin_amdgcn_sched_barrier(0);
        const u32x2 xv = *(const u32x2*)(xt + (pt * 32 + r32) * 136 + lt * 32 + 8 * rg + 4 * hh);
#pragma unroll
        for (int i = 0; i < 4; i++) {
          const int reg = rg * 4 + i;
          const int l = lt * 32 + 8 * rg + 4 * hh + i;
          const uint32_t xw = (i < 2) ? xv.x : xv.y;
          const float xval = (i & 1) ? bfhi(xw) : bflo(xw);
          const float y = acc[pt][reg] + dsk * xval;
          const float z = bf2f((uint32_t)zraw[pt][reg]);
          const float t = y * silu(z);
          ss[reg] += t * t;
          if (!dry) *(u16*)((char*)ZS + (zoff0 + (uint32_t)(((reg & 3) + 8 * (reg >> 2)) * 2048 + pt * 64))) = f2bf(t);
        }
      }
  }
#pragma unroll
  for (int reg = 0; reg < 16; reg++) {
    float v = ss[reg];
#pragma unroll
    for (int o = 1; o < 32; o <<= 1) v += __shfl_xor(v, o);
    if (r32 == 0) part[hg * 128 + lt * 32 + (reg & 3) + 8 * (reg >> 2) + 4 * hh] = v;
  }
  __syncthreads();
  if (tid < 128 && !dry) ((float*)(p.ws + OFF_RSTD))[(tok0 + tid) * 2 + g] = rsqrtf((part[tid] + part[128 + tid]) * (1.f / 512.f) + EPS);
  __syncthreads();
}

__device__ __forceinline__ void attn_item(const Params& p, char* smem, int item, float lam, bool dry, int* qctr, int* s_next) {
  const int h = 7 - (item >> 7), qb = 63 - ((item & 127) >> 1), b = item & 1, bh = b * 8 + h;
  constexpr int KVSTAGE = 64 * 136 + 128 * 72;
  u16* KV = (u16*)smem;
  float* ex = (float*)(KV + 2 * KVSTAGE);
  const int tid = threadIdx.x, lane = tid & 63, w = tid >> 6, r32 = lane & 31, hh = lane >> 5;
  const int qt = w & 3, m = w >> 2;
  const int qpos0 = qb * 128 + qt * 32, qpos = qpos0 + r32;
  const float slope2 = __builtin_amdgcn_exp2f(-(float)(h + 1)) * LOG2E;
  const u16* Qb = (const u16*)(p.ws + OFF_Q);
  const u16* Kb = (const u16*)(p.ws + OFF_K) + (size_t)(b * 8192) * 1024 + h * 128;
  const u16* Vb = (const u16*)(p.ws + OFF_VT) + (size_t)(bh * 128) * 8192;
  u32x4 rk[2], rv[2];
  auto gload = [&](int kt) {
    const int J0 = kt * 64;
#pragma unroll
    for (int i = 0; i < 2; i++) {
      const int id = tid + 512 * i;
      rk[i] = *(const u32x4*)(Kb + (size_t)(J0 + (id >> 4)) * 1024 + (id & 15) * 8);
      rv[i] = *(const u32x4*)(Vb + (size_t)(id >> 3) * 8192 + J0 + (id & 7) * 8);
    }
  };
  auto lstore = [&](int stage) {
    u16* Ks = KV + stage * KVSTAGE;
    u16* Vs = Ks + 64 * 136;
#pragma unroll
    for (int i = 0; i < 2; i++) {
      const int id = tid + 512 * i;
      *(u32x4*)(Ks + (id >> 4) * 136 + (id & 15) * 8) = rk[i];
      u32x2 v0, v1; v0.x = rv[i].x; v0.y = rv[i].y; v1.x = rv[i].z; v1.y = rv[i].w;
      u16* vd = Vs + (id >> 3) * 72 + ((id & 7) >> 1) * 16 + ((id & 1) ? 4 : 0);
      *(u32x2*)(vd) = v0;
      *(u32x2*)(vd + 8) = v1;
    }
  };
  const int nkt = 2 * qb + 2;
  gload(nkt - 1);
  bf16x8 qf[4];
  {
    const u16* qptr = Qb + (size_t)(b * 8192 + qpos) * 1024 + h * 128 + m * 64 + hh * 8;
#pragma unroll
    for (int ks = 0; ks < 4; ks++) qf[ks] = *(const bf16x8*)(qptr + ks * 16);
  }
  float bound2;
  {
    float qn2 = 0.f;
#pragma unroll
    for (int ks = 0; ks < 4; ks++) {
      const u32x4 qw = __builtin_bit_cast(u32x4, qf[ks]);
      qn2 += bflo(qw.x) * bflo(qw.x) + bfhi(qw.x) * bfhi(qw.x) + bflo(qw.y) * bflo(qw.y) + bfhi(qw.y) * bfhi(qw.y);
      qn2 += bflo(qw.z) * bflo(qw.z) + bfhi(qw.z) * bfhi(qw.z) + bflo(qw.w) * bflo(qw.w) + bfhi(qw.w) * bfhi(qw.w);
    }
    qn2 += __shfl_xor(qn2, 32);
    const float kmax2 = __uint_as_float(((const unsigned int*)(p.ws + OFF_KMAX))[bh * 2 + m]);
    bound2 = sqrtf(qn2 * kmax2) * 1.02f;
  }
  bool wdone = false, first = true, fast = false;
  f32x16 O[4];
#pragma unroll
  for (int d = 0; d < 4; d++)
#pragma unroll
    for (int r = 0; r < 16; r++) O[d][r] = 0.f;
  float mrow = -INFINITY, lsum = 0.f;
  lstore((nkt - 1) & 1);
  __syncthreads();
  if (__builtin_amdgcn_readfirstlane(threadIdx.x) >= 256) __builtin_amdgcn_s_setprio(1);
  for (int kt = nkt - 1; kt >= 0; kt--) {
    const int J0 = kt * 64;
    const u16* Ks = KV + (kt & 1) * KVSTAGE;
    const u16* Vs = Ks + 64 * 136;
    if (kt > 0) gload(kt - 1);
    if (fast && !wdone && J0 + 64 <= qpos0) {
      const float base1 = slope2 * (float)(J0 + 32 + 4 * hh - qpos) - mrow;
      const float base0 = base1 - 32.f * slope2;
      f32x16 S1, S0;
#pragma unroll
      for (int reg = 0; reg < 16; reg++) {
        const float c = (float)((reg & 3) + 8 * (reg >> 2));
        S1[reg] = fmaf(slope2, c, base1);
        S0[reg] = fmaf(slope2, c, base0);
      }
#pragma unroll
      for (int ks = 0; ks < 4; ks++) {
        const bf16x8 k1 = *(const bf16x8*)(Ks + (32 + r32) * 136 + m * 64 + ks * 16 + hh * 8);
        const bf16x8 k0 = *(const bf16x8*)(Ks + r32 * 136 + m * 64 + ks * 16 + hh * 8);
        S1 = MFMA32(k1, qf[ks], S1);
        S0 = MFMA32(k0, qf[ks], S0);
      }
      float ps = 0.f;
#pragma unroll
      for (int sub = 1; sub >= 0; sub--) {
        uint32_t pw[8];
#pragma unroll
        for (int j = 0; j < 8; j++) {
          const float p0 = __builtin_amdgcn_exp2f(sub ? S1[2 * j] : S0[2 * j]);
          const float p1 = __builtin_amdgcn_exp2f(sub ? S1[2 * j + 1] : S0[2 * j + 1]);
          ps += p0 + p1;
          pw[j] = pack2(p0, p1);
        }
        u32x4 t0, t1; t0.x = pw[0]; t0.y = pw[1]; t0.z = pw[2]; t0.w = pw[3]; t1.x = pw[4]; t1.y = pw[5]; t1.z = pw[6]; t1.w = pw[7];
        const bf16x8 pf0 = __builtin_bit_cast(bf16x8, t0), pf1 = __builtin_bit_cast(bf16x8, t1);
#pragma unroll
        for (int d = 0; d < 4; d++)
#pragma unroll
          for (int sp = 0; sp < 2; sp++) {
            const bf16x8 vfr = *(const bf16x8*)(Vs + (d * 32 + r32) * 72 + sub * 32 + sp * 16 + hh * 8);
            O[d] = MFMA32(vfr, sp ? pf1 : pf0, O[d]);
          }
      }
      lsum += ps;
    } else
#pragma unroll
    for (int sub = 1; sub >= 0; sub--) {
      const int Js = J0 + sub * 32;
      if (!wdone && Js <= qpos0 + 31) {
        const float ref = first ? 0.f : mrow;
        const float base = slope2 * (float)(Js + 4 * hh - qpos) - ref;
        f32x16 S;
#pragma unroll
        for (int reg = 0; reg < 16; reg++) S[reg] = fmaf(slope2, (float)((reg & 3) + 8 * (reg >> 2)), base);
        bf16x8 kf[4];
#pragma unroll
        for (int ks = 0; ks < 4; ks++) kf[ks] = *(const bf16x8*)(Ks + (sub * 32 + r32) * 136 + m * 64 + ks * 16 + hh * 8);
        bf16x8 vf[4][2];
#pragma unroll
        for (int d = 0; d < 4; d++)
#pragma unroll
          for (int sp = 0; sp < 2; sp++) {
            vf[d][sp] = *(const bf16x8*)(Vs + (d * 32 + r32) * 72 + sub * 32 + sp * 16 + hh * 8);
          }
#pragma unroll
        for (int ks = 0; ks < 4; ks++) S = MFMA32(kf[ks], qf[ks], S);
        if (!fast) {
          const bool diag = (Js + 31 > qpos0);
          float mx = -INFINITY;
#pragma unroll
          for (int reg = 0; reg < 16; reg++) {
            const int key = Js + (reg & 3) + 8 * (reg >> 2) + 4 * hh;
            if (diag && key > qpos) S[reg] = -INFINITY;
            mx = fmaxf(mx, S[reg]);
          }
          mx = fmaxf(mx, __shfl_xor(mx, 32));
          const float mrel = first ? mx : fmaxf(mx, 0.f);
          const float alpha = first ? 0.f : __builtin_amdgcn_exp2f(-mrel);
          if (__any(alpha != 1.f)) {
#pragma unroll
            for (int d = 0; d < 4; d++)
#pragma unroll
              for (int r = 0; r < 16; r++) O[d][r] *= alpha;
            lsum *= alpha;
          }
          mrow = ref + mrel;
#pragma unroll
          for (int reg = 0; reg < 16; reg++) S[reg] -= mrel;
          first = false;
          fast = __all(bound2 - mrow <= 100.f);
        }
        float ps = 0.f;
        uint32_t pw[8];
#pragma unroll
        for (int j = 0; j < 8; j++) {
          const float p0 = __builtin_amdgcn_exp2f(S[2 * j]), p1 = __builtin_amdgcn_exp2f(S[2 * j + 1]);
          ps += p0 + p1;
          pw[j] = pack2(p0, p1);
        }
        lsum += ps;
        u32x4 t0, t1; t0.x = pw[0]; t0.y = pw[1]; t0.z = pw[2]; t0.w = pw[3]; t1.x = pw[4]; t1.y = pw[5]; t1.z = pw[6]; t1.w = pw[7];
        const bf16x8 pf0 = __builtin_bit_cast(bf16x8, t0), pf1 = __builtin_bit_cast(bf16x8, t1);
#pragma unroll
        for (int d = 0; d < 4; d++) {
#pragma unroll
          for (int sp = 0; sp < 2; sp++) O[d] = MFMA32(vf[d][sp], sp ? pf1 : pf0, O[d]);
        }
      }
    }
    if (!wdone) wdone = __all((bound2 - slope2 * (float)(qpos - (J0 - 1)) - mrow) < -40.f);
    if (kt > 0) lstore((kt - 1) & 1);
    if (!__syncthreads_or(!wdone)) break;
  }
  __builtin_amdgcn_s_setprio(0);
  int nxt = 0;
  if (tid == 256 && qctr) nxt = atomicAdd(qctr, 1);
  u32x2 zpre[4][4];
  {
    const uint32_t zoff = ((uint32_t)(b * 8192 + qpos) * 1024u + (uint32_t)(h * 128 + 4 * hh)) * 2u;
#pragma unroll
    for (int d = 0; d < 4; d++)
#pragma unroll
      for (int rg = 0; rg < 4; rg++)
        zpre[d][rg] = (m == 0) ? *(const u32x2*)((const char*)p.ws + OFF_ZA + (zoff + (uint32_t)((d * 32 + 8 * rg) * 2))) : u32x2{0u, 0u};
  }
  lsum += __shfl_xor(lsum, 32);
  const float inv = 1.f / lsum;
  if (m == 1) {
    const float sc = inv * lam;
#pragma unroll
    for (int d = 0; d < 4; d++)
#pragma unroll
      for (int reg = 0; reg < 16; reg++)
        ex[(qt * 128 + d * 32 + (reg & 3) + 8 * (reg >> 2) + 4 * hh) * 32 + r32] = O[d][reg] * sc;
  }
  __syncthreads();
  if (m == 0 && !dry) {
    float ssq = 0.f;
#pragma unroll
    for (int d = 0; d < 4; d++)
#pragma unroll
      for (int reg = 0; reg < 16; reg++) {
        const float v = O[d][reg] * inv - ex[(qt * 128 + d * 32 + (reg & 3) + 8 * (reg >> 2) + 4 * hh) * 32 + r32];
        O[d][reg] = v; ssq += v * v;
      }
    ssq += __shfl_xor(ssq, 32);
    const float rs = rsqrtf(ssq * (1.f / 128.f) + EPS) * 0.8f;
    const size_t rowoff = (size_t)(b * 8192 + qpos) * 1024 + h * 128;
    u16* YA = (u16*)(p.ws + OFF_Q);
#pragma unroll
    for (int d = 0; d < 4; d++)
#pragma unroll
      for (int rg = 0; rg < 4; rg++) {
        const int dv0 = d * 32 + 8 * rg + 4 * hh;
        const u32x2 zv = zpre[d][rg];
        const float4 sg = *(const float4*)(p.subln_gain + dv0);
        u32x2 o;
        o.x = pack2(O[d][rg * 4 + 0] * rs * sg.x * silu(bflo(zv.x)), O[d][rg * 4 + 1] * rs * sg.y * silu(bfhi(zv.x)));
        o.y = pack2(O[d][rg * 4 + 2] * rs * sg.z * silu(bflo(zv.y)), O[d][rg * 4 + 3] * rs * sg.w * silu(bfhi(zv.y)));
        *(u32x2*)(YA + rowoff + dv0) = o;
      }
  }
  if (tid == 256 && qctr) *s_next = nxt;
  __syncthreads();
}

__device__ __forceinline__ void phase_final(const Params& p) {
  const int tid = threadIdx.x, lane = tid & 63, wid = tid >> 6;
  for (int row0 = (blockIdx.x * 8 + wid) * 8; row0 < T_; row0 += gridDim.x * 64) {
    float4 v[8][4]; float ss[8];
#pragma unroll
    for (int r = 0; r < 8; r++) {
      const float4* orow = (const float4*)(p.out + (size_t)(row0 + r) * 1024);
#pragma unroll
      for (int i = 0; i < 4; i++) v[r][i] = orow[lane + 64 * i];
    }
#pragma unroll
    for (int r = 0; r < 8; r++) {
      float t = 0.f;
#pragma unroll
      for (int i = 0; i < 4; i++) t += v[r][i].x * v[r][i].x + v[r][i].y * v[r][i].y + v[r][i].z * v[r][i].z + v[r][i].w * v[r][i].w;
      ss[r] = rsqrtf(wave_sum(t) * (1.f / 1024.f) + EPS);
    }
#pragma unroll
    for (int i = 0; i < 4; i++) {
      const float4 g = ((const float4*)p.final_gain)[lane + 64 * i];
#pragma unroll
      for (int r = 0; r < 8; r++) {
        const float rs = ss[r];
        float4 o; o.x = v[r][i].x * rs * g.x; o.y = v[r][i].y * rs * g.y; o.z = v[r][i].z * rs * g.z; o.w = v[r][i].w * rs * g.w;
        ((float4*)(p.out + (size_t)(row0 + r) * 1024))[lane + 64 * i] = o;
      }
    }
  }
}

#ifndef PROBE
#define PROBE 0
#endif
__global__ void __launch_bounds__(512) fwd_megakernel(Params p) {
  cg::grid_group grid = cg::this_grid();
  extern __shared__ __attribute__((aligned(16))) char smem[];
  __shared__ int s_item;
  __shared__ uint4 xb_words;
  if (threadIdx.x == 0) xb_words = make_uint4(0u, 0u, 0u, 0u);
  __syncthreads();
  const XcdBarrier xb = xcd_barrier_post((unsigned*)(p.ws + OFF_BAR), (volatile LAS unsigned*)&xb_words);
#define GSYNC() xcd_barrier(xb)
  if (p.out == nullptr) grid.sync();
  phase_prep(p, smem);
  GSYNC();
  if (threadIdx.x == 0) {
    unsigned* bar = (unsigned*)(p.ws + OFF_BAR);
    unsigned pre = 0u;
    for (unsigned jx = 0; jx < xb.x; ++jx) pre += xb_ld(&bar[XB_XCNT(jx)]);
    const unsigned v = pre + xb_words.z;
    xb_words.w = (gridDim.x == 256) ? ((v & 31u) * 8u + (v >> 5)) : v;
  }
  __syncthreads();
#if PROBE == 2
  phase_prep(p, smem);
  GSYNC();
  if (threadIdx.x == 0) {
    unsigned* bar = (unsigned*)(p.ws + OFF_BAR);
    unsigned pre = 0u;
    for (unsigned jx = 0; jx < xb.x; ++jx) pre += xb_ld(&bar[XB_XCNT(jx)]);
    const unsigned v = pre + xb_words.z;
    xb_words.w = (gridDim.x == 256) ? ((v & 31u) * 8u + (v >> 5)) : v;
  }
  __syncthreads();
#endif
  gemm_phase<0>(p, smem, false, (int)xb_words.w);
  GSYNC();
#if PROBE == 1
  gemm_phase<0>(p, smem, false, (int)xb_words.w);
  GSYNC();
#endif
  phase_states(p, smem);
  GSYNC();
  phase_scan(p);
  GSYNC();
#if PROBE == 3
  phase_states(p, smem);
  GSYNC();
  phase_scan(p);
  GSYNC();
#endif
#if PROBE == 7
  for (int it = blockIdx.x; it < 256; it += gridDim.x) ssd_out_item(p, smem, it, true);
#endif
#if PROBE == 6
  GSYNC(); GSYNC(); GSYNC(); GSYNC(); GSYNC(); GSYNC();
#endif
  for (int it = blockIdx.x; it < 256; it += gridDim.x) ssd_out_item(p, smem, it, false);
  {
    const int lane = threadIdx.x & 63;
    const float s1 = wave_sum(p.lq1[lane] * p.lk1[lane]);
    const float s2 = wave_sum(p.lq2[lane] * p.lk2[lane]);
    const float lam = __expf(s1) - __expf(s2) + 0.2f;
    int* ctr = (int*)(p.ws + OFF_CTR);
#if PROBE == 4
    while (true) {
      if (threadIdx.x == 0) s_item = atomicAdd(ctr + 1, 1);
      __syncthreads();
      const int item = s_item;
      __syncthreads();
      if (item >= 1024) break;
      attn_item(p, smem, item, lam, true, nullptr, nullptr);
    }
#endif
    if (threadIdx.x == 0) s_item = atomicAdd(ctr, 1);
    __syncthreads();
    int item = s_item;
    __syncthreads();
    while (item < 1024) {
      attn_item(p, smem, item, lam, false, ctr, &s_item);
      item = s_item;
    }
  }
  GSYNC();
#if PROBE == 5
  gemm_phase<1>(p, smem, true, (int)xb_words.w);
  GSYNC();
#endif
  gemm_phase<1>(p, smem, false, (int)xb_words.w);
  GSYNC();
  phase_final(p);
}

extern "C" void kernel_launch(void* const* d_in, const int* in_sizes, int n_in, void* d_out, int out_size,
                              void* d_ws, size_t ws_size, hipStream_t stream) {
  static int grid_blocks = 0;
  if (grid_blocks == 0) {
    int dev = 0, cus = 0, per_cu = 0;
    hipGetDevice(&dev);
    hipDeviceGetAttribute(&cus, hipDeviceAttributeMultiprocessorCount, dev);
    if (ws_size < WS_NEED || out_size != T_ * 1024) { fprintf(stderr, "workspace too small: %zu < %zu\n", ws_size, (size_t)WS_NEED); grid_blocks = -1; return; }
    if (hipFuncSetAttribute((const void*)fwd_megakernel, hipFuncAttributeMaxDynamicSharedMemorySize, LDS_BYTES) != hipSuccess) {
      fprintf(stderr, "hipFuncSetAttribute failed\n"); grid_blocks = -1; return;
    }
    hipOccupancyMaxActiveBlocksPerMultiprocessor(&per_cu, (const void*)fwd_megakernel, 512, LDS_BYTES);
    if (per_cu < 1) { fprintf(stderr, "occupancy query says %d blocks/CU\n", per_cu); grid_blocks = -1; return; }
    grid_blocks = cus;
  }
  if (grid_blocks < 0) return;
  Params p{};
  p.x = (const float*)d_in[0]; p.norm_gain = (const float*)d_in[1]; p.w_in = (const float*)d_in[2];
  p.conv_w = (const float*)d_in[3]; p.conv_b = (const float*)d_in[4]; p.dt_bias = (const float*)d_in[5];
  p.a_log = (const float*)d_in[6]; p.d_skip = (const float*)d_in[7]; p.ssd_norm_gain = (const float*)d_in[8];
  p.lq1 = (const float*)d_in[9]; p.lk1 = (const float*)d_in[10]; p.lq2 = (const float*)d_in[11];
  p.lk2 = (const float*)d_in[12]; p.subln_gain = (const float*)d_in[13]; p.w_out = (const float*)d_in[14];
  p.final_gain = (const float*)d_in[15];
  p.out = (float*)d_out; p.ws = (char*)d_ws;
  if (hipMemsetAsync((char*)d_ws + OFF_CTR, 0, 256 + XCD_BAR_WORDS * 4, stream) != hipSuccess) { fprintf(stderr, "memset failed\n"); return; }
  void* args[] = {&p};
  hipError_t e = hipLaunchCooperativeKernel((const void*)fwd_megakernel, dim3(grid_blocks), dim3(512), args, LDS_BYTES, stream);
  if (e != hipSuccess) fprintf(stderr, "cooperative launch failed: %s (grid %d)\n", hipGetErrorString(e), grid_blocks);
}
```
